# Optimizing an MI355X kernel written in HIP

```python
import math
import jax, jax.numpy as jnp
from jax import lax
import numpy as np

D_MODEL = 1024
BATCH = 32
SEQ = 256
DEPTH = 2
DEC_BATCH = 8
DEC_SEQ = 1024
PAST_LEN = 512

GRID_W = 64
HEAD_DIM = 64
Q_BLOCK = 128
EPS = 1e-6
ROPE_BASE = 10000.0

LRU_WIDTH = 256
LRU_BLOCKS = 4
LRU_BW = LRU_WIDTH // LRU_BLOCKS
LRU_C = 8.0
CONV_W = 4
CONV_LEFT = 2

GQA_Q_HEADS = 4
GQA_KV_HEADS = 2
GQA_WIDTH = GQA_Q_HEADS * HEAD_DIM
GQA_KV_WIDTH = GQA_KV_HEADS * HEAD_DIM

DIFF_HEADS = 4
DIFF_WIDTH = DIFF_HEADS * 2 * HEAD_DIM

D_MIX = LRU_WIDTH + GQA_WIDTH + DIFF_WIDTH
IN_SIZES = (LRU_WIDTH, LRU_WIDTH, GQA_WIDTH, GQA_KV_WIDTH, GQA_KV_WIDTH, GQA_WIDTH,
            DIFF_WIDTH, DIFF_WIDTH, DIFF_WIDTH, DIFF_WIDTH)
N_IN = sum(IN_SIZES)
IN_OFFSETS = tuple(sum(IN_SIZES[:i + 1]) for i in range(len(IN_SIZES) - 1))

kernel_name = "hybrid_dit_lru_gqa_diffattn_step"


def lambda_init(layer):
    return 0.8 - 0.6 * math.exp(-0.3 * layer)


def rms_norm(x, g):
    xf = x.astype(jnp.float32)
    y = xf * lax.rsqrt(jnp.mean(xf * xf, axis=-1, keepdims=True) + EPS)
    return (y * g.astype(jnp.float32)).astype(x.dtype)


def centred_dwconv(x, w, b):
    T = x.shape[1]
    xp = jnp.pad(x, ((0, 0), (CONV_LEFT, CONV_W - 1 - CONV_LEFT), (0, 0)))
    out = xp[:, 0:T] * w[0] + b
    for j in range(1, CONV_W):
        out = out + xp[:, j:j + T] * w[j]
    return out


def _rotate(x, ang):
    half = x.shape[-1] // 2
    x1, x2 = x[..., :half], x[..., half:]
    cos = jnp.cos(ang)[None, :, None, :]
    sin = jnp.sin(ang)[None, :, None, :]
    return jnp.concatenate([x1 * cos - x2 * sin, x2 * cos + x1 * sin], axis=-1)


def axial_rope(x, n_rows):
    d = x.shape[-1]
    quarter = d // 4
    inv = jnp.power(ROPE_BASE, -jnp.arange(quarter, dtype=jnp.float32) / quarter)
    row = jnp.repeat(jnp.arange(n_rows, dtype=jnp.float32), GRID_W)
    col = jnp.tile(jnp.arange(GRID_W, dtype=jnp.float32), n_rows)
    xf = x.astype(jnp.float32)
    half = d // 2
    out = jnp.concatenate([_rotate(xf[..., :half], row[:, None] * inv[None]),
                           _rotate(xf[..., half:], col[:, None] * inv[None])], axis=-1)
    return out.astype(x.dtype)


def gqa_attend(q, k, v):
    B, Tq, Hq, d = q.shape
    Hkv = k.shape[2]
    G = Hq // Hkv
    nb = Tq // Q_BLOCK
    scale = HEAD_DIM ** -0.5
    qb = q.reshape(B, nb, Q_BLOCK, Hkv, G, d).swapaxes(0, 1)

    def one(qblk):
        s = jnp.einsum('bqhgd,bkhd->bhgqk', qblk, k).astype(jnp.float32) * scale
        p = jax.nn.softmax(s, axis=-1).astype(v.dtype)
        return jnp.einsum('bhgqk,bkhd->bqhgd', p, v)

    o = lax.map(one, qb)
    return o.swapaxes(0, 1).reshape(B, Tq, Hq * v.shape[-1])


def diff_attend(q, k, v, lam):
    B, Tq, H, _, d = q.shape
    nb = Tq // Q_BLOCK
    scale = HEAD_DIM ** -0.5
    qb = q.reshape(B, nb, Q_BLOCK, H, 2, d).swapaxes(0, 1)

    def one(qblk):
        s = jnp.einsum('bqhcd,bkhcd->bhcqk', qblk, k).astype(jnp.float32) * scale
        p = jax.nn.softmax(s, axis=-1)
        w = p[:, :, 0] - lam * p[:, :, 1]
        return jnp.einsum('bhqk,bkhe->bqhe', w.astype(v.dtype), v)

    o = lax.map(one, qb)
    return o.swapaxes(0, 1).reshape(B, Tq, H, v.shape[-1])


def rglru_scan(u, wa, ba, wx, bx, lam, h0, reverse):
    B, T, W = u.shape
    ub = u.reshape(B, T, LRU_BLOCKS, LRU_BW)
    r = jax.nn.sigmoid(jnp.einsum('btnc,ncd->btnd', ub, wa).reshape(B, T, W) + ba)
    i = jax.nn.sigmoid(jnp.einsum('btnc,ncd->btnd', ub, wx).reshape(B, T, W) + bx)
    log_a = -LRU_C * r.astype(jnp.float32) * jax.nn.softplus(-lam.astype(jnp.float32))
    a = jnp.exp(log_a)
    inp = jnp.sqrt(-jnp.expm1(2.0 * log_a)) * (i * u).astype(jnp.float32)

    def step(h, xs):
        a_t, x_t = xs
        h = a_t * h + x_t
        return h, h

    hT, ys = lax.scan(step, h0.astype(jnp.float32),
                      (a.swapaxes(0, 1), inp.swapaxes(0, 1)), reverse=reverse)
    return ys.swapaxes(0, 1).astype(u.dtype), hT.astype(u.dtype)


def mixer(h, p, layer, ctx):
    B, T, _ = h.shape
    z = h @ p['w_in']
    (lru_x, lru_g, gq, gk, gv, gg, dq, dk, dv, dg) = jnp.split(z, IN_OFFSETS, axis=-1)

    u = centred_dwconv(lru_x, p['conv_w'], p['conv_b'])
    if ctx is None:
        h0 = jnp.zeros((B, 2, LRU_WIDTH), dtype=u.dtype)
    else:
        h0 = ctx[4]
    yf, hf = rglru_scan(u, p['wa'][0], p['ba'][0], p['wx'][0], p['bx'][0], p['lam'][0],
                        h0[:, 0], reverse=False)
    yb, hb = rglru_scan(u, p['wa'][1], p['ba'][1], p['wx'][1], p['bx'][1], p['lam'][1],
                        h0[:, 1], reverse=True)
    lru_out = (yf + yb) * jax.nn.silu(lru_g)
    lru_state = jnp.stack([hf, hb], axis=1)

    q = rms_norm(gq.reshape(B, T, GQA_Q_HEADS, HEAD_DIM), p['gqa_gq'])
    k = rms_norm(gk.reshape(B, T, GQA_KV_HEADS, HEAD_DIM), p['gqa_gk'])
    v = gv.reshape(B, T, GQA_KV_HEADS, HEAD_DIM)

    dqr = dq.reshape(B, T, DIFF_HEADS, 2, HEAD_DIM)
    dkr = dk.reshape(B, T, DIFF_HEADS, 2, HEAD_DIM)
    dvr = dv.reshape(B, T, DIFF_HEADS, 2 * HEAD_DIM)

    if ctx is None:
        k_all, v_all, dk_all, dv_all = k, v, dkr, dvr
    else:
        n_rows = T // GRID_W
        q = axial_rope(q, n_rows)
        k_all = jnp.concatenate([ctx[0], axial_rope(k, n_rows)], axis=1)
        v_all = jnp.concatenate([ctx[1], v], axis=1)
        dqr = axial_rope(dqr.reshape(B, T, 2 * DIFF_HEADS, HEAD_DIM), n_rows).reshape(dqr.shape)
        dk_rot = axial_rope(dkr.reshape(B, T, 2 * DIFF_HEADS, HEAD_DIM), n_rows).reshape(dkr.shape)
        dk_all = jnp.concatenate([ctx[2], dk_rot], axis=1)
        dv_all = jnp.concatenate([ctx[3], dvr], axis=1)

    gqa_out = gqa_attend(q, k_all, v_all) * jax.nn.silu(gg)

    dl = p['diff_lam'].astype(jnp.float32)
    lam_i = lambda_init(layer)
    lam = jnp.exp(jnp.sum(dl[0] * dl[1])) - jnp.exp(jnp.sum(dl[2] * dl[3])) + lam_i
    do = diff_attend(dqr, dk_all, dv_all, lam)
    do = rms_norm(do, p['diff_gsub']) * (1.0 - lam_i)
    diff_out = do.reshape(B, T, DIFF_WIDTH) * jax.nn.silu(dg)

    out = jnp.concatenate([lru_out, gqa_out, diff_out], axis=-1) @ p['w_out']
    return out, (k, v, dkr, dvr, lru_state)


def adaln_prenorm(x, cond, w_mod, b_mod, g_pre):
    mod = jax.nn.silu(cond) @ w_mod + b_mod
    shift, scale, gate = jnp.split(mod[:, None, :], 3, axis=-1)
    return rms_norm(x, g_pre) * (1.0 + scale) + shift, gate


def setup_inputs(seed: int = 0) -> dict:
    key = jax.random.key(seed)
    ks = jax.random.split(key, 32)
    f32 = jnp.float32
    nrm = lambda k, s: jax.random.normal(k, s, dtype=f32)
    a_init = jax.random.uniform(ks[20], (DEPTH, 2, LRU_WIDTH), dtype=f32, minval=0.9, maxval=0.999)
    s_init = a_init ** (1.0 / LRU_C)
    return {
        "x_prompt": nrm(ks[0], (BATCH, SEQ, D_MODEL)),
        "x_sample": nrm(ks[1], (DEC_BATCH, DEC_SEQ, D_MODEL)),
        "cache_gqa_k": nrm(ks[2], (DEC_BATCH, DEPTH, PAST_LEN, GQA_KV_HEADS, HEAD_DIM)),
        "cache_gqa_v": nrm(ks[3], (DEC_BATCH, DEPTH, PAST_LEN, GQA_KV_HEADS, HEAD_DIM)),
        "cache_diff_k": nrm(ks[4], (DEC_BATCH, DEPTH, PAST_LEN, DIFF_HEADS, 2, HEAD_DIM)),
        "cache_diff_v": nrm(ks[5], (DEC_BATCH, DEPTH, PAST_LEN, DIFF_HEADS, 2 * HEAD_DIM)),
        "state_lru": 0.5 * nrm(ks[6], (DEC_BATCH, DEPTH, 2, LRU_WIDTH)),
        "c": nrm(ks[7], (DEC_BATCH, D_MODEL)),
        "c_ctx": nrm(ks[8], (D_MODEL,)),
        "w_mod": 0.5 * D_MODEL ** -0.5 * nrm(ks[9], (DEPTH, D_MODEL, 3 * D_MODEL)),
        "b_mod": 0.02 * nrm(ks[10], (DEPTH, 3 * D_MODEL)),
        "g_pre": 1.0 + 0.02 * nrm(ks[11], (DEPTH, D_MODEL)),
        "g_post": 1.0 + 0.02 * nrm(ks[12], (DEPTH, D_MODEL)),
        "w_in": D_MODEL ** -0.5 * nrm(ks[13], (DEPTH, D_MODEL, N_IN)),
        "w_out": D_MIX ** -0.5 * nrm(ks[14], (DEPTH, D_MIX, D_MODEL)),
        "lru_conv_w": CONV_W ** -0.5 * nrm(ks[15], (DEPTH, CONV_W, LRU_WIDTH)),
        "lru_conv_b": 0.02 * nrm(ks[16], (DEPTH, LRU_WIDTH)),
        "lru_wa": LRU_BW ** -0.5 * nrm(ks[17], (DEPTH, 2, LRU_BLOCKS, LRU_BW, LRU_BW)),
        "lru_ba": 0.02 * nrm(ks[18], (DEPTH, 2, LRU_WIDTH)),
        "lru_wx": LRU_BW ** -0.5 * nrm(ks[19], (DEPTH, 2, LRU_BLOCKS, LRU_BW, LRU_BW)),
        "lru_bx": 0.02 * nrm(ks[21], (DEPTH, 2, LRU_WIDTH)),
        "lru_lambda": jnp.log(s_init) - jnp.log1p(-s_init),
        "gqa_gq": 1.0 + 0.02 * nrm(ks[22], (DEPTH, HEAD_DIM)),
        "gqa_gk": 1.0 + 0.02 * nrm(ks[23], (DEPTH, HEAD_DIM)),
        "diff_lam": 0.1 * nrm(ks[24], (DEPTH, 4, HEAD_DIM)),
        "diff_gsub": 1.0 + 0.02 * nrm(ks[25], (DEPTH, 2 * HEAD_DIM)),
    }


def reference(x_prompt, x_sample, cache_gqa_k, cache_gqa_v, cache_diff_k, cache_diff_v, state_lru,
              c, c_ctx, w_mod, b_mod, g_pre, g_post, w_in, w_out, lru_conv_w, lru_conv_b,
              lru_wa, lru_ba, lru_wx, lru_bx, lru_lambda, gqa_gq, gqa_gk, diff_lam, diff_gsub):
    def layer_params(l):
        return {'w_in': w_in[l], 'w_out': w_out[l], 'conv_w': lru_conv_w[l], 'conv_b': lru_conv_b[l],
                'wa': lru_wa[l], 'ba': lru_ba[l], 'wx': lru_wx[l], 'bx': lru_bx[l],
                'lam': lru_lambda[l], 'gqa_gq': gqa_gq[l], 'gqa_gk': gqa_gk[l],
                'diff_lam': diff_lam[l], 'diff_gsub': diff_gsub[l]}

    x = x_prompt
    gks, gvs, dks, dvs, sts = [], [], [], [], []
    for l in range(DEPTH):
        p = layer_params(l)
        h, gate = adaln_prenorm(x, c_ctx[None, :], w_mod[l], b_mod[l], g_pre[l])
        y, (gk, gv, dk, dv, st) = mixer(h, p, l, None)
        x = x + gate * rms_norm(y, g_post[l])
        gks.append(gk); gvs.append(gv); dks.append(dk); dvs.append(dv); sts.append(st)
    y_prompt = x

    x = x_sample
    for l in range(DEPTH):
        p = layer_params(l)
        h, gate = adaln_prenorm(x, c, w_mod[l], b_mod[l], g_pre[l])
        ctx = (cache_gqa_k[:, l], cache_gqa_v[:, l], cache_diff_k[:, l], cache_diff_v[:, l],
               state_lru[:, l])
        y, _ = mixer(h, p, l, ctx)
        x = x + gate * rms_norm(y, g_post[l])
    y_sample = x

    new_gqa_k = jnp.stack(gks, axis=1)
    new_gqa_v = jnp.stack(gvs, axis=1)
    new_diff_k = jnp.stack(dks, axis=1)
    new_diff_v = jnp.stack(dvs, axis=1)
    new_lru = jnp.stack(sts, axis=1)
    return (y_prompt, y_sample, new_gqa_k, new_gqa_v, new_diff_k, new_diff_v, new_lru)
```

```cpp
#include <hip/hip_runtime.h>
#include <cstdio>
#include <cstdint>

#define DI __device__ __forceinline__
#define LAS __attribute__((address_space(3)))
typedef unsigned short bf16;
typedef short bf16x8 __attribute__((ext_vector_type(8)));
typedef short s16x4 __attribute__((ext_vector_type(4)));
typedef float f32x2 __attribute__((ext_vector_type(2)));
typedef float f32x4 __attribute__((ext_vector_type(4)));
typedef float f32x16 __attribute__((ext_vector_type(16)));
typedef unsigned u32x2 __attribute__((ext_vector_type(2)));
typedef unsigned u32x4 __attribute__((ext_vector_type(4)));

constexpr int DM = 1024, NIN = 3328, NTOK = 16384, NCTX = 8192;
constexpr int CTX_T = 256, LAT_T = 1024, LAT_TK = 1536;
constexpr float EPS = 1e-6f;
constexpr float QSCALE = 0.18033688011112042f;
constexpr int NTHREADS = 512;

constexpr size_t MiB = 1u << 20;
constexpr size_t WS_CTL = 0, CTL_BYTES = 64 * 1024;
constexpr size_t WS_MOD = 1 * MiB;
constexpr size_t WS_ROPE = 1 * MiB + 256 * 1024;
constexpr size_t WS_MISC = 1 * MiB + 320 * 1024;
constexpr size_t WS_WG = 1 * MiB + 512 * 1024;
constexpr size_t WS_WIN = 2 * MiB;
constexpr size_t WS_WOUT = 15 * MiB;
constexpr size_t WS_HM = 20 * MiB;
constexpr size_t WS_LX = 52 * MiB;
constexpr size_t WS_GS = 68 * MiB;
constexpr size_t WS_QG = 100 * MiB;
constexpr size_t WS_QD = 108 * MiB;
constexpr size_t WS_KGC = 124 * MiB;
constexpr size_t WS_VGC = 126 * MiB;
constexpr size_t WS_KDC = 128 * MiB;
constexpr size_t WS_VDC = 136 * MiB;
constexpr size_t WS_KGL = 144 * MiB;
constexpr size_t WS_VGL = 147 * MiB;
constexpr size_t WS_KDL = 150 * MiB;
constexpr size_t WS_VDL = 162 * MiB;
constexpr size_t WS_R1 = 174 * MiB;
constexpr size_t WS_YF = 238 * MiB;
constexpr size_t WS_YB = WS_LX;
constexpr size_t WS_END = 254 * MiB;
constexpr int CW_QUEUE = 64;
constexpr int CW_BAR = 1024;

constexpr size_t OUT_GK = 16777216, OUT_GV = 18874368, OUT_DK = 20971520, OUT_DV = 29360128, OUT_LRU = 37748736;

constexpr int LDS_BYTES = 147456;
constexpr int LDS_CTRL = LDS_BYTES - 1024;

DI unsigned pk2(float a, float b) {
    typedef __bf16 b2 __attribute__((ext_vector_type(2)));
    f32x2 v = {a, b};
    return __builtin_bit_cast(unsigned, __builtin_convertvector(v, b2));
}
DI float bflo(unsigned u) { return __uint_as_float(u << 16); }
DI float bfhi(unsigned u) { return __uint_as_float(u & 0xffff0000u); }
DI float silu_f(float x) { return x / (1.f + __expf(-x)); }
DI float sigm_f(float x) { return 1.f / (1.f + __expf(-x)); }
#define LDS_WAIT() asm volatile("s_waitcnt lgkmcnt(0)" ::: "memory")
#define VM_WAIT() asm volatile("s_waitcnt vmcnt(0)" ::: "memory")
#define MFMA32(a, b, c) __builtin_amdgcn_mfma_f32_32x32x16_bf16((a), (b), (c), 0, 0, 0)

struct Params {
    const float* in[26];
    float* out;
    unsigned char* ws;
    int ph_lo, ph_hi;
};
enum { I_XP = 0, I_XS, I_CGK, I_CGV, I_CDK, I_CDV, I_SLRU, I_C, I_CCTX, I_WMOD, I_BMOD, I_GPRE, I_GPOST, I_WIN, I_WOUT, I_CONVW, I_CONVB,
       I_WA, I_BA, I_WX, I_BX, I_LAM, I_GQ, I_GK, I_DLAM, I_GSUB };

namespace pg8 {
#define PG8_LAS __attribute__((address_space(3)))
typedef unsigned short bf16_t;
typedef short bf16x8 __attribute__((ext_vector_type(8)));
typedef float f32x4 __attribute__((ext_vector_type(4)));
typedef unsigned u32x4 __attribute__((ext_vector_type(4)));
constexpr int BM = 256, BK = 64, HALF = 128, HTB = HALF * BK * 2  , STAGE_BYTES = 8 * HTB, NXCD = 8, WGM = 8;

__host__ __device__ __forceinline__ int lds_byte(int r, int c) { const int st = (r >> 4) * 2 + (c >> 5), rr = r & 15, cc = c & 31, ob = rr * 64 + cc * 2; return st * 1024 + (ob ^ (((ob >> 9) & 1) << 5)); }
__host__ __device__ __forceinline__ void stage_rc(int b, int& R, int& C) { const int st = b / 1024, sb = b % 1024, swz = sb ^ (((sb >> 9) & 1) << 5); R = (st >> 1) * 16 + swz / 64; C = (st & 1) * 32 + (swz % 64) / 2; }
__host__ __device__ __forceinline__ int perm32(int rho) { const int n = rho >> 4, i = rho & 15; return 8 * (i >> 2) + 4 * n + (i & 3); }

struct Unit { int pm, pn; };
struct Gemm { const bf16_t* A; const bf16_t* Bt; int M, N, K; };

struct StaticOrder {
    int nM, nN, nwg, G, c;
    __host__ __device__ void init(int M, int N, int G_, int c_) { nM = M / BM; nN = N / BM; nwg = nM * nN; G = G_; c = c_; }
    __host__ __device__ bool next(int i, Unit& u) const {
        const long L = (long)i * G + c; if (L >= nwg) return false;
        int wgid = (int)L; { const int q = nwg / NXCD, r = nwg % NXCD, xcd = wgid % NXCD, off = wgid / NXCD; wgid = (xcd < r ? xcd * (q + 1) : r * (q + 1) + (xcd - r) * q) + off; }
        const int nig = WGM * nN, gid = wgid / nig, fm = gid * WGM, gsz = (nM - fm) < WGM ? (nM - fm) : WGM;
        u.pm = fm + ((wgid % nig) % gsz); u.pn = (wgid % nig) / gsz; return true;
    }
    __device__ __forceinline__ void a_ready(const Unit&) const {}
    __device__ __forceinline__ void done(const Unit&) const {}
};


struct EpiY {
    static constexpr bool PERM = false, AFTER_DRAIN = false;
    float* Y;
    __device__ __forceinline__ void operator()(const f32x4 (&acc)[2][2][4][2], const Unit& u, int wr, int wc, int fr_, int fq_) const {
        int fr = fr_, fq = fq_;
        asm volatile("" : "+v"(fr), "+v"(fq));
#pragma unroll
        for (int ai = 0; ai < 2; ++ai)
#pragma unroll
            for (int m = 0; m < 4; ++m) {
                float* rowp = Y + (size_t)(u.pm * BM + ai * HALF + wr * 64 + m * 16 + fr) * 1024 + u.pn * BM + wc * 32 + 4 * fq;
#pragma unroll
                for (int bj = 0; bj < 2; ++bj)
#pragma unroll
                    for (int n = 0; n < 2; ++n) *(f32x4*)(rowp + bj * HALF + n * 16) = acc[ai][bj][m][n];
            }
    }
};

struct EpiIn {
    static constexpr bool PERM = false, AFTER_DRAIN = false;
    int l;
    float* out;
    unsigned char* ws;
    const float* gq; const float* gk;
    __device__ __forceinline__ static void rope(f32x4 (&v)[2][2], const float* ropetab, int t, int fq) {
#pragma unroll
        for (int bj = 0; bj < 2; ++bj) {
            const int pos = bj == 0 ? (t >> 6) : (t & 63);
            const f32x4 cs0 = *(const f32x4*)(ropetab + (pos * 16 + 4 * fq) * 2), cs1 = *(const f32x4*)(ropetab + (pos * 16 + 4 * fq) * 2 + 4);
            const float c[4] = {cs0[0], cs0[2], cs1[0], cs1[2]}, s[4] = {cs0[1], cs0[3], cs1[1], cs1[3]};
#pragma unroll
            for (int e = 0; e < 4; ++e) { const float x1 = v[bj][0][e], x2 = v[bj][1][e]; v[bj][0][e] = x1 * c[e] - x2 * s[e]; v[bj][1][e] = x2 * c[e] + x1 * s[e]; }
        }
    }
    __device__ __forceinline__ static float headnorm(const f32x4 (&v)[2][2]) {
        float ss = 0.f;
#pragma unroll
        for (int bj = 0; bj < 2; ++bj)
#pragma unroll
            for (int n = 0; n < 2; ++n) ss += (v[bj][n][0] * v[bj][n][0] + v[bj][n][1] * v[bj][n][1]) + (v[bj][n][2] * v[bj][n][2] + v[bj][n][3] * v[bj][n][3]);
        ss += __shfl_xor(ss, 16); ss += __shfl_xor(ss, 32);
        return 1.0f / sqrtf(ss * (1.0f / 64.0f) + EPS);
    }
    __device__ __forceinline__ void operator()(const f32x4 (&acc)[2][2][4][2], const Unit& u, int wr, int wc, int fr_, int fq_) const {
        int fr = fr_, fq = fq_;
        asm volatile("" : "+v"(fr), "+v"(fq));
        const int g = 4 * u.pn + wc;
        const bool lat = u.pm >= 32;
        const int b = lat ? ((u.pm - 32) >> 2) : u.pm, tbase = lat ? ((u.pm - 32) & 3) * 256 : 0;
        const float* ropetab = (const float*)(ws + WS_ROPE);
        int kind, idx;
        if (g < 4) { kind = 0; idx = g; } else if (g < 8) { kind = 1; idx = 64 * (g - 4); } else if (g < 12) { kind = 2; idx = g - 8; } else if (g < 14) { kind = 3; idx = g - 12; }
        else if (g < 16) { kind = 4; idx = g - 14; } else if (g < 20) { kind = 1; idx = 256 + 64 * (g - 16); } else if (g < 28) { kind = 5; idx = g - 20; } else if (g < 36) { kind = 6; idx = g - 28; }
        else if (g < 44) { kind = 7; idx = g - 36; } else { kind = 1; idx = 512 + 64 * (g - 44); }
        float gw[2][2][4];
        if (kind == 2 || kind == 3) { const float* gsrc = kind == 2 ? gq : gk;
#pragma unroll
            for (int bj = 0; bj < 2; ++bj)
#pragma unroll
                for (int n = 0; n < 2; ++n) { const f32x4 t4 = *(const f32x4*)(gsrc + 32 * bj + 16 * n + 4 * fq); gw[bj][n][0] = t4[0]; gw[bj][n][1] = t4[1]; gw[bj][n][2] = t4[2]; gw[bj][n][3] = t4[3]; } }
#pragma unroll
        for (int ai = 0; ai < 2; ++ai)
#pragma unroll
            for (int m = 0; m < 4; ++m) {
                const int rt = ai * HALF + wr * 64 + m * 16 + fr, mrow = u.pm * BM + rt, t = tbase + rt;
                f32x4 v[2][2];
#pragma unroll
                for (int bj = 0; bj < 2; ++bj)
#pragma unroll
                    for (int n = 0; n < 2; ++n) v[bj][n] = acc[ai][bj][m][n];
                if (kind == 0) {
                    float* dst = (float*)(ws + WS_LX) + (size_t)mrow * 256 + 64 * idx + 4 * fq;
#pragma unroll
                    for (int bj = 0; bj < 2; ++bj)
#pragma unroll
                        for (int n = 0; n < 2; ++n) *(f32x4*)(dst + 32 * bj + 16 * n) = v[bj][n];
                } else if (kind == 1) {
                    bf16_t* dst = (bf16_t*)(ws + WS_GS) + (size_t)mrow * 1024 + idx + 4 * fq;
#pragma unroll
                    for (int bj = 0; bj < 2; ++bj)
#pragma unroll
                        for (int n = 0; n < 2; ++n) { u32x2 w; w.x = pk2(silu_f(v[bj][n][0]), silu_f(v[bj][n][1])); w.y = pk2(silu_f(v[bj][n][2]), silu_f(v[bj][n][3])); *(u32x2*)(dst + 32 * bj + 16 * n) = w; }
                } else if (kind == 2 || kind == 5) {
                    if (kind == 2) { const float rs = headnorm(v);
#pragma unroll
                        for (int bj = 0; bj < 2; ++bj)
#pragma unroll
                            for (int n = 0; n < 2; ++n)
#pragma unroll
                                for (int e = 0; e < 4; ++e) v[bj][n][e] *= rs * gw[bj][n][e]; }
                    if (lat) rope(v, ropetab, t, fq);
                    bf16_t* dst = (kind == 2 ? (bf16_t*)(ws + WS_QG) + (size_t)mrow * 256 : (bf16_t*)(ws + WS_QD) + (size_t)mrow * 512) + 64 * idx + 4 * fq;
#pragma unroll
                    for (int bj = 0; bj < 2; ++bj)
#pragma unroll
                        for (int n = 0; n < 2; ++n) { u32x2 w; w.x = pk2(v[bj][n][0] * QSCALE, v[bj][n][1] * QSCALE); w.y = pk2(v[bj][n][2] * QSCALE, v[bj][n][3] * QSCALE); *(u32x2*)(dst + 32 * bj + 16 * n) = w; }
                } else if (kind == 3 || kind == 6) {
                    if (kind == 3) { const float rs = headnorm(v);
#pragma unroll
                        for (int bj = 0; bj < 2; ++bj)
#pragma unroll
                            for (int n = 0; n < 2; ++n)
#pragma unroll
                                for (int e = 0; e < 4; ++e) v[bj][n][e] *= rs * gw[bj][n][e]; }
                    bf16_t* dst;
                    if (!lat) {
                        float* o = kind == 3 ? out + OUT_GK + ((size_t)(b * 2 + l) * 256 + t) * 128 + 64 * idx + 4 * fq : out + OUT_DK + ((size_t)(b * 2 + l) * 256 + t) * 512 + 64 * idx + 4 * fq;
#pragma unroll
                        for (int bj = 0; bj < 2; ++bj)
#pragma unroll
                            for (int n = 0; n < 2; ++n) *(f32x4*)(o + 32 * bj + 16 * n) = v[bj][n];
                        dst = kind == 3 ? (bf16_t*)(ws + WS_KGC) + ((size_t)(b * 2 + idx) * 256 + t) * 64 : (bf16_t*)(ws + WS_KDC) + ((size_t)(b * 8 + idx) * 256 + t) * 64;
                    } else {
                        rope(v, ropetab, t, fq);
                        dst = kind == 3 ? (bf16_t*)(ws + WS_KGL) + ((size_t)(b * 2 + idx) * 1536 + 512 + t) * 64 : (bf16_t*)(ws + WS_KDL) + ((size_t)(b * 8 + idx) * 1536 + 512 + t) * 64;
                    }
                    dst += 4 * fq;
#pragma unroll
                    for (int bj = 0; bj < 2; ++bj)
#pragma unroll
                        for (int n = 0; n < 2; ++n) { u32x2 w; w.x = pk2(v[bj][n][0], v[bj][n][1]); w.y = pk2(v[bj][n][2], v[bj][n][3]); *(u32x2*)(dst + 32 * bj + 16 * n) = w; }
                } else {
                    bf16_t* dst; int pitch, key;
                    if (!lat) {
                        float* o = kind == 4 ? out + OUT_GV + ((size_t)(b * 2 + l) * 256 + t) * 128 + 64 * idx + 4 * fq : out + OUT_DV + ((size_t)(b * 2 + l) * 256 + t) * 512 + 64 * idx + 4 * fq;
#pragma unroll
                        for (int bj = 0; bj < 2; ++bj)
#pragma unroll
                            for (int n = 0; n < 2; ++n) *(f32x4*)(o + 32 * bj + 16 * n) = v[bj][n];
                        pitch = 256; key = t;
                        dst = kind == 4 ? (bf16_t*)(ws + WS_VGC) + (size_t)(b * 2 + idx) * 64 * 256 : (bf16_t*)(ws + WS_VDC) + ((size_t)(b * 4 + (idx >> 1)) * 128 + 64 * (idx & 1)) * 256;
                    } else {
                        pitch = 1536; key = 512 + t;
                        dst = kind == 4 ? (bf16_t*)(ws + WS_VGL) + (size_t)(b * 2 + idx) * 64 * 1536 : (bf16_t*)(ws + WS_VDL) + ((size_t)(b * 4 + (idx >> 1)) * 128 + 64 * (idx & 1)) * 1536;
                    }
#pragma unroll
                    for (int bj = 0; bj < 2; ++bj)
#pragma unroll
                        for (int n = 0; n < 2; ++n) { const unsigned w0 = pk2(v[bj][n][0], v[bj][n][1]), w1 = pk2(v[bj][n][2], v[bj][n][3]);
                            bf16_t* d0 = dst + (size_t)(32 * bj + 16 * n + 4 * fq) * pitch + key;
                            d0[0] = (bf16_t)(w0 & 0xffffu); d0[pitch] = (bf16_t)(w0 >> 16); d0[2 * pitch] = (bf16_t)(w1 & 0xffffu); d0[3 * pitch] = (bf16_t)(w1 >> 16); }
                }
            }
    }
};
template <class Epi, class Sched, bool ALIGN_EPI = false, bool SP2 = false>
__device__ __forceinline__ void gemm_phase(PG8_LAS unsigned char* lds, const Gemm g, const Sched& S, const Epi& E) {
    const int tid = threadIdx.x, wid = __builtin_amdgcn_readfirstlane(tid >> 6), lane = tid & 63, wr = wid >> 2, wc = wid & 3, fr = lane & 15, fq = lane >> 4;
    const int K = g.K, nt = K / BK;
    unsigned voffA[2], voffB[2];
#pragma unroll
    for (int i = 0; i < 2; ++i) { int R, C; stage_rc(tid * 16 + i * 8192, R, C); const int Rb = Epi::PERM ? ((R & ~31) + perm32(R & 31)) : R;
        voffA[i] = (unsigned)(R * K + C) * 2u; voffB[i] = (unsigned)(Rb * K + C) * 2u; }
    const size_t kstep = (size_t)(BK * 2);
    const size_t hstep = (size_t)HALF * K * 2;
    const size_t tstep = 2 * hstep;
    const unsigned ldsw = (unsigned)wid * 1024u;
    const int aoff = lds_byte(wr * 64 + fr, fq * 8), boff = lds_byte(wc * 32 + fr, fq * 8);
#define PG8_SA(b, h) (((b) * 2 + (h)) * HTB)
#define PG8_SB(b, h) ((4 + (b) * 2 + (h)) * HTB)
#define PG8_STAGE(bufoff, gbase, voff) do { _Pragma("unroll") for (int _i = 0; _i < 2; ++_i) \
        __builtin_amdgcn_global_load_lds((const unsigned*)((const char*)(gbase) + (voff)[_i]), (PG8_LAS unsigned*)(lds + (bufoff) + ldsw + _i * 8192), 16, 0, 0); } while (0)
#define PG8_LDA(dst, b, h) do { _Pragma("unroll") for (int m = 0; m < 4; ++m) _Pragma("unroll") for (int k = 0; k < 2; ++k) dst[m][k] = *(const PG8_LAS bf16x8*)(lds + PG8_SA(b, h) + aoff + m * 2048 + k * 1024); } while (0)
#define PG8_LDB(dst, b, h) do { _Pragma("unroll") for (int n = 0; n < 2; ++n) _Pragma("unroll") for (int k = 0; k < 2; ++k) dst[n][k] = *(const PG8_LAS bf16x8*)(lds + PG8_SB(b, h) + boff + n * 2048 + k * 1024); } while (0)
#define PG8_MMA(ai, bj, At, Bt) do { __builtin_amdgcn_s_setprio(1); _Pragma("unroll") for (int m = 0; m < 4; ++m) _Pragma("unroll") for (int n = 0; n < 2; ++n) _Pragma("unroll") for (int k = 0; k < 2; ++k) \
        acc[ai][bj][m][n] = __builtin_amdgcn_mfma_f32_16x16x32_bf16(Bt[n][k], At[m][k], acc[ai][bj][m][n], 0, 0, 0); __builtin_amdgcn_s_setprio(0); } while (0)
#define PG8_WAIT_V(n) asm volatile("s_waitcnt vmcnt(" #n ")" ::: "memory")
#define PG8_WAIT_L(n) asm volatile("s_waitcnt lgkmcnt(" #n ")" ::: "memory")
#define PG8_BAR __builtin_amdgcn_s_barrier()
#define PG8_SCHED __builtin_amdgcn_sched_barrier(0)
    Unit cur, nxt; int ui = 0;
    if (!S.next(0, cur)) return;
    f32x4 acc[2][2][4][2];
#pragma unroll
    for (int a = 0; a < 2; ++a)
#pragma unroll
        for (int b = 0; b < 2; ++b)
#pragma unroll
            for (int m = 0; m < 4; ++m)
#pragma unroll
                for (int n = 0; n < 2; ++n) acc[a][b][m][n] = (f32x4){0.f, 0.f, 0.f, 0.f};
    bf16x8 At[4][2], B0[2][2], B1[2][2];
    const char* cA = (const char*)g.A + (size_t)cur.pm * tstep; const char* cB = (const char*)g.Bt + (size_t)cur.pn * tstep;
    S.a_ready(cur);
    if constexpr (SP2) {
        PG8_STAGE(PG8_SB(0, 0), cB, voffB); PG8_STAGE(PG8_SB(0, 1), cB + hstep, voffB); PG8_STAGE(PG8_SA(0, 0), cA, voffA); PG8_STAGE(PG8_SA(0, 1), cA + hstep, voffA);
        if (wr == 1) PG8_BAR;
        PG8_WAIT_V(2); PG8_BAR;
        PG8_STAGE(PG8_SB(1, 0), cB + kstep, voffB); PG8_STAGE(PG8_SA(1, 0), cA + kstep, voffA); PG8_STAGE(PG8_SB(1, 1), cB + hstep + kstep, voffB);
        PG8_WAIT_V(6); PG8_BAR;
    } else {
        PG8_STAGE(PG8_SB(0, 0), cB, voffB); PG8_STAGE(PG8_SA(0, 0), cA, voffA); PG8_STAGE(PG8_SB(0, 1), cB + hstep, voffB); PG8_STAGE(PG8_SA(0, 1), cA + hstep, voffA);
        if (wr == 1) PG8_BAR;
        PG8_WAIT_V(4); PG8_BAR;
        PG8_STAGE(PG8_SB(1, 0), cB + kstep, voffB); PG8_STAGE(PG8_SA(1, 0), cA + kstep, voffA); PG8_STAGE(PG8_SB(1, 1), cB + hstep + kstep, voffB);
        PG8_WAIT_V(6); PG8_BAR;
    }
    for (;;) {
        const bool has_next = S.next(ui + 1, nxt);
        const char* nA = has_next ? (const char*)g.A + (size_t)nxt.pm * tstep : cA; const char* nB = has_next ? (const char*)g.Bt + (size_t)nxt.pn * tstep : cB;
        for (int t = 0; t < nt; t += 2) {
            const bool last = (t == nt - 2);
            const char* a1 = cA + (size_t)(t + 1) * kstep;
            const char* a2 = last ? nA : cA + (size_t)(t + 2) * kstep; const char* b2 = last ? nB : cB + (size_t)(t + 2) * kstep;
            const char* a3 = a2 + kstep; const char* b3 = b2 + kstep;
            if (last && has_next) S.a_ready(nxt);
            if constexpr (SP2) {
            PG8_LDB(B0, 0, 0); PG8_LDB(B1, 0, 1); PG8_SCHED; PG8_LDA(At, 0, 0); PG8_STAGE(PG8_SA(1, 1), a1 + hstep, voffA);
            PG8_WAIT_V(8); PG8_WAIT_L(0); PG8_BAR; PG8_MMA(0, 0, At, B0); PG8_MMA(0, 1, At, B1); PG8_BAR; PG8_SCHED;
            PG8_LDA(At, 0, 1); PG8_STAGE(PG8_SB(0, 0), b2, voffB); PG8_STAGE(PG8_SB(0, 1), b2 + hstep, voffB); PG8_STAGE(PG8_SA(0, 0), a2, voffA);
            PG8_WAIT_V(8); PG8_WAIT_L(0); PG8_BAR; PG8_MMA(1, 0, At, B0); PG8_MMA(1, 1, At, B1); PG8_BAR; PG8_SCHED;
            PG8_LDB(B0, 1, 0); PG8_LDB(B1, 1, 1); PG8_SCHED; PG8_LDA(At, 1, 0); PG8_STAGE(PG8_SA(0, 1), a2 + hstep, voffA);
            PG8_WAIT_V(8); PG8_WAIT_L(0); PG8_BAR; PG8_MMA(0, 0, At, B0); PG8_MMA(0, 1, At, B1); PG8_BAR; PG8_SCHED;
            PG8_LDA(At, 1, 1); PG8_STAGE(PG8_SB(1, 0), b3, voffB); PG8_STAGE(PG8_SB(1, 1), b3 + hstep, voffB); PG8_STAGE(PG8_SA(1, 0), a3, voffA);
            PG8_WAIT_V(8); PG8_WAIT_L(0); PG8_BAR; PG8_MMA(1, 0, At, B0); PG8_MMA(1, 1, At, B1); PG8_BAR; PG8_SCHED;
            } else {
            PG8_LDB(B0, 0, 0); PG8_SCHED; PG8_LDA(At, 0, 0); PG8_STAGE(PG8_SA(1, 1), a1 + hstep, voffA);
            PG8_WAIT_L(8); PG8_BAR; PG8_WAIT_L(0); PG8_MMA(0, 0, At, B0); PG8_BAR; PG8_SCHED;
            PG8_LDB(B1, 0, 1); PG8_STAGE(PG8_SB(0, 0), b2, voffB);
            PG8_BAR; PG8_WAIT_L(0); PG8_MMA(0, 1, At, B1); PG8_BAR;
            PG8_LDA(At, 0, 1); PG8_STAGE(PG8_SA(0, 0), a2, voffA);
            PG8_BAR; PG8_WAIT_L(0); PG8_MMA(1, 0, At, B0); PG8_BAR; PG8_SCHED;
            PG8_STAGE(PG8_SB(0, 1), b2 + hstep, voffB);
            PG8_WAIT_V(6); PG8_BAR; PG8_MMA(1, 1, At, B1); PG8_BAR;
            PG8_LDB(B0, 1, 0); PG8_SCHED; PG8_LDA(At, 1, 0); PG8_STAGE(PG8_SA(0, 1), a2 + hstep, voffA);
            PG8_WAIT_L(8); PG8_BAR; PG8_WAIT_L(0); PG8_MMA(0, 0, At, B0); PG8_BAR; PG8_SCHED;
            PG8_LDB(B1, 1, 1); PG8_STAGE(PG8_SB(1, 0), b3, voffB);
            PG8_BAR; PG8_WAIT_L(0); PG8_MMA(0, 1, At, B1); PG8_BAR;
            PG8_LDA(At, 1, 1); PG8_STAGE(PG8_SA(1, 0), a3, voffA);
            PG8_BAR; PG8_WAIT_L(0); PG8_MMA(1, 0, At, B0); PG8_BAR; PG8_SCHED;
            PG8_STAGE(PG8_SB(1, 1), b3 + hstep, voffB);
            PG8_WAIT_V(6); PG8_BAR; PG8_MMA(1, 1, At, B1); PG8_BAR;
            }
        }
        if constexpr (ALIGN_EPI) { if (wr == 0) PG8_BAR; }
        if constexpr (!Epi::AFTER_DRAIN) { E(acc, cur, wr, wc, fr, fq); S.done(cur); }
        if (!has_next) break;
#pragma unroll
        for (int a = 0; a < 2; ++a)
#pragma unroll
            for (int b = 0; b < 2; ++b)
#pragma unroll
                for (int m = 0; m < 4; ++m)
#pragma unroll
                    for (int n = 0; n < 2; ++n) acc[a][b][m][n] = (f32x4){0.f, 0.f, 0.f, 0.f};
        cur = nxt; cA = nA; cB = nB; ++ui;
        if constexpr (ALIGN_EPI) { if (wr == 1) PG8_BAR; }
    }
    PG8_WAIT_V(0);
    if constexpr (!ALIGN_EPI) { if (wr == 0) PG8_BAR; }
    PG8_BAR;
    if constexpr (Epi::AFTER_DRAIN) { E.fused(acc, cur, wr, wc, fr, fq, lds, wid, lane); S.done(cur); }
#undef PG8_SA
#undef PG8_SB
#undef PG8_STAGE
#undef PG8_LDA
#undef PG8_LDB
#undef PG8_MMA
#undef PG8_WAIT_V
#undef PG8_WAIT_L
#undef PG8_BAR
#undef PG8_SCHED
}
}
#define XB_TMO      128
#define XB_XCNT(j)  (256  + 64 * (j))
#define XB_XSUB(j)  (1280 + 64 * (j))
#define XB_XGEN(j)  (2304 + 64 * (j))
#define XB_TOP      3328
#define XB_TOPGEN   3392
#define XCD_BAR_WORDS 3456
#define XB_SPIN_CAP (1u << 18)
#define LAS __attribute__((address_space(3)))

__device__ __forceinline__ unsigned xb_ld(unsigned* p)              { return __hip_atomic_load(p, __ATOMIC_RELAXED, __HIP_MEMORY_SCOPE_AGENT); }
__device__ __forceinline__ unsigned xb_add(unsigned* p, unsigned v) { return __hip_atomic_fetch_add(p, v, __ATOMIC_RELAXED, __HIP_MEMORY_SCOPE_AGENT); }
__device__ __forceinline__ unsigned xb_xcc_id() { return (unsigned)__builtin_amdgcn_s_getreg((3 << 11) | 20) & 0xFu; }
#define XB_SPIN(cond, bar) do { unsigned _sp = 0; while (cond) { __builtin_amdgcn_s_sleep(1); \
    if ((++_sp & 255u) == 0u) { if (xb_ld(&(bar)[XB_TMO])) break; if (_sp > XB_SPIN_CAP) { atomicAdd(&(bar)[XB_TMO], 1u); break; } } } } while (0)

struct XcdBarrier {
    unsigned* bar; unsigned x;
    volatile LAS unsigned* st;
};

__device__ __forceinline__ XcdBarrier xcd_barrier_post(unsigned* bar, volatile LAS unsigned* st) {
    XcdBarrier b; b.bar = bar; b.x = xb_xcc_id(); b.st = st;
    if (threadIdx.x == 0) (void)xb_add(&bar[XB_XCNT(b.x)], 1u);
    return b;
}
__device__ __forceinline__ void xcd_barrier_complete(unsigned* bar, unsigned x, unsigned& nloc, unsigned& nx) {
    const unsigned G = gridDim.x * gridDim.y * gridDim.z;
    unsigned sum, cnt, mine, sp = 0u;
    for (;;) {
        sum = 0u; cnt = 0u; mine = 0u;
#pragma unroll
        for (unsigned j = 0; j < 16; ++j) { const unsigned c = xb_ld(&bar[XB_XCNT(j)]); sum += c; cnt += (c > 0u) ? 1u : 0u; mine = (j == x) ? c : mine; }
        if (sum == G) break;
        __builtin_amdgcn_s_sleep(1);
        if ((++sp & 255u) == 0u) { if (xb_ld(&bar[XB_TMO])) break; if (sp > XB_SPIN_CAP) { atomicAdd(&bar[XB_TMO], 1u); break; } }
    }
    nloc = mine > 0u ? mine : 1u; nx = cnt > 0u ? cnt : 1u;
}

__device__ __forceinline__ void xcd_barrier(const XcdBarrier& b) {
    asm volatile("s_waitcnt vmcnt(0)" ::: "memory");
    __syncthreads();
    if (threadIdx.x == 0) {
        unsigned* bar = b.bar;
        __builtin_amdgcn_s_waitcnt(0);
        unsigned nloc = b.st[0], nx = b.st[1];
        if (nloc == 0u) { xcd_barrier_complete(bar, b.x, nloc, nx); b.st[0] = nloc; b.st[1] = nx; }
        const unsigned old = xb_add(&bar[XB_XSUB(b.x)], 1u);
        const unsigned gen = old / nloc;
        if (old + 1u == (gen + 1u) * nloc) {
            __builtin_amdgcn_fence(__ATOMIC_RELEASE, "agent");
            asm volatile("s_waitcnt vmcnt(0)" ::: "memory");
            const unsigned og = xb_add(&bar[XB_TOP], 1u);
            const unsigned tg = og / nx;
            if (og + 1u == (tg + 1u) * nx) xb_add(&bar[XB_TOPGEN], 1u);
            else XB_SPIN(xb_ld(&bar[XB_TOPGEN]) == tg, bar);
            __builtin_amdgcn_fence(__ATOMIC_ACQUIRE, "agent");
            xb_add(&bar[XB_XGEN(b.x)], 1u);
            asm volatile("s_waitcnt vmcnt(0)" ::: "memory");
        } else {
            XB_SPIN(xb_ld(&bar[XB_XGEN(b.x)]) == gen, bar);
            __builtin_amdgcn_fence(__ATOMIC_ACQUIRE, "agent");
            asm volatile("s_waitcnt vmcnt(0)" ::: "memory");
        }
    }
    __syncthreads();
}

struct Ctx {
    int tid, lane, wave, G, bid;
    unsigned char* lds;
};

__device__ const double ROPE_INV[16] = {1.0, 0.56234132519034907, 0.31622776601683794, 0.17782794100389229, 0.1, 0.056234132519034911, 0.031622776601683791, 0.017782794100389229,
                                        0.01, 0.005623413251903491, 0.0031622776601683794, 0.0017782794100389228, 0.001, 0.0005623413251903491, 0.00031622776601683794, 0.00017782794100389227};
DI void sincos_d(double x, double& s, double& c) {
    const double kd = rint(x * 0.63661977236758134308);
    const int k = (int)kd;
    double r = fma(-kd, 1.57079632679489655800e+00, x); r = fma(-kd, 6.12323399573676603587e-17, r);
    const double r2 = r * r;
    const double sp = r * (1.0 + r2 * (-1.0 / 6.0 + r2 * (1.0 / 120.0 + r2 * (-1.0 / 5040.0 + r2 * (1.0 / 362880.0 + r2 * (-1.0 / 39916800.0 + r2 * (1.0 / 6227020800.0)))))));
    const double cp = 1.0 + r2 * (-0.5 + r2 * (1.0 / 24.0 + r2 * (-1.0 / 720.0 + r2 * (1.0 / 40320.0 + r2 * (-1.0 / 3628800.0 + r2 * (1.0 / 479001600.0 + r2 * (-1.0 / 87178291200.0)))))));
    const int q = k & 3;
    s = q == 0 ? sp : q == 1 ? cp : q == 2 ? -sp : -cp;
    c = q == 0 ? cp : q == 1 ? -sp : q == 2 ? -cp : sp;
}

DI void phase_mod(const Params& p, const Ctx& c) {
    float* sc = (float*)c.lds;
    float* red = sc + 9 * 1024;
    const float* cond = p.in[I_C]; const float* cctx = p.in[I_CCTX];
    for (int i = c.tid; i < 9 * 1024; i += NTHREADS) { const int cc = i >> 10, k = i & 1023; const float v = cc == 0 ? cctx[k] : cond[(cc - 1) * 1024 + k]; sc[i] = silu_f(v); }
    __syncthreads();
    float* mod = (float*)(p.ws + WS_MOD);
    const float* wmod = p.in[I_WMOD]; const float* bmod = p.in[I_BMOD];
    for (int u = c.bid; u < 192; u += c.G) {
        const int l = u / 96, j0 = (u % 96) * 32, col = c.tid & 31, kg = c.tid >> 5;
        const float* w = wmod + (size_t)l * 1024 * 3072 + j0 + col;
        float acc[9];
#pragma unroll
        for (int cc = 0; cc < 9; ++cc) acc[cc] = 0.f;
#pragma unroll 8
        for (int kk = 0; kk < 64; ++kk) { const int k = kg * 64 + kk; const float wv = w[(size_t)k * 3072];
#pragma unroll
            for (int cc = 0; cc < 9; ++cc) acc[cc] += sc[cc * 1024 + k] * wv; }
#pragma unroll
        for (int cc = 0; cc < 9; ++cc) red[(kg * 9 + cc) * 32 + col] = acc[cc];
        __syncthreads();
        if (c.tid < 288) { const int cc = c.tid >> 5, c2 = c.tid & 31; float s = 0.f;
#pragma unroll
            for (int g = 0; g < 16; ++g) s += red[(g * 9 + cc) * 32 + c2];
            mod[(size_t)(l * 9 + cc) * 3072 + j0 + c2] = s + bmod[l * 3072 + j0 + c2]; }
        __syncthreads();
    }
    if (c.bid == c.G - 1) {
        float* rt = (float*)(p.ws + WS_ROPE);
        for (int i = c.tid; i < 1024; i += NTHREADS) { const int pos = i >> 4, k = i & 15; double s, co; sincos_d((double)pos * ROPE_INV[k], s, co); rt[2 * i] = (float)co; rt[2 * i + 1] = (float)s; }
        if (c.tid < 2) { const float* dl = p.in[I_DLAM] + c.tid * 256; float s01 = 0.f, s23 = 0.f;
            for (int i = 0; i < 64; ++i) { s01 += dl[i] * dl[64 + i]; s23 += dl[128 + i] * dl[192 + i]; }
            const float lam_i = c.tid == 0 ? 0.2f : 0.35550906759096934f;
            ((float*)(p.ws + WS_MISC))[c.tid] = expf(s01) - expf(s23) + lam_i; }
    }
}

DI void rows_pass(const Params& p, const Ctx& c, int post_l, int pre_l) {
    const float* mod = (const float*)(p.ws + WS_MOD);
    const float* Y = (const float*)(p.ws + WS_R1);
    bf16* H = (bf16*)(p.ws + WS_HM);
    const int gw = c.bid * 8 + c.wave, NGW = c.G * 8;
    for (int m = gw; m < NTOK; m += NGW) {
        const int cidx = m < NCTX ? 0 : 1 + ((m - NCTX) >> 10);
        const float* xrow = post_l == 1 ? p.out + (size_t)m * 1024 : (m < NCTX ? p.in[I_XP] + (size_t)m * 1024 : p.in[I_XS] + (size_t)(m - NCTX) * 1024);
        f32x4 v[4];
#pragma unroll
        for (int j = 0; j < 4; ++j) v[j] = *(const f32x4*)(xrow + 256 * j + 4 * c.lane);
        if (post_l >= 0) {
            f32x4 y[4]; float ss = 0.f;
#pragma unroll
            for (int j = 0; j < 4; ++j) { y[j] = *(const f32x4*)(Y + (size_t)m * 1024 + 256 * j + 4 * c.lane); ss += (y[j][0] * y[j][0] + y[j][1] * y[j][1]) + (y[j][2] * y[j][2] + y[j][3] * y[j][3]); }
#pragma unroll
            for (int o = 1; o < 64; o <<= 1) ss += __shfl_xor(ss, o);
            const float rs = 1.0f / sqrtf(ss * (1.0f / 1024.0f) + EPS);
            const float* gate = mod + (size_t)(post_l * 9 + cidx) * 3072 + 2048; const float* gp = p.in[I_GPOST] + post_l * 1024;
#pragma unroll
            for (int j = 0; j < 4; ++j) { const f32x4 g4 = *(const f32x4*)(gate + 256 * j + 4 * c.lane), p4 = *(const f32x4*)(gp + 256 * j + 4 * c.lane);
                v[j] = v[j] + g4 * (y[j] * rs * p4);
                *(f32x4*)(p.out + (size_t)m * 1024 + 256 * j + 4 * c.lane) = v[j]; }
        }
        if (pre_l >= 0) {
            float ss = 0.f;
#pragma unroll
            for (int j = 0; j < 4; ++j) ss += (v[j][0] * v[j][0] + v[j][1] * v[j][1]) + (v[j][2] * v[j][2] + v[j][3] * v[j][3]);
#pragma unroll
            for (int o = 1; o < 64; o <<= 1) ss += __shfl_xor(ss, o);
            const float rs = 1.0f / sqrtf(ss * (1.0f / 1024.0f) + EPS);
            const float* sh = mod + (size_t)(pre_l * 9 + cidx) * 3072; const float* scl = sh + 1024; const float* gpre = p.in[I_GPRE] + pre_l * 1024;
#pragma unroll
            for (int j = 0; j < 4; ++j) { const f32x4 s4 = *(const f32x4*)(sh + 256 * j + 4 * c.lane), c4 = *(const f32x4*)(scl + 256 * j + 4 * c.lane), g4 = *(const f32x4*)(gpre + 256 * j + 4 * c.lane);
                const f32x4 h = (v[j] * rs * g4) * (c4 + 1.0f) + s4;
                u32x2 w; w.x = pk2(h[0], h[1]); w.y = pk2(h[2], h[3]);
                *(u32x2*)(H + (size_t)m * 1024 + 256 * j + 4 * c.lane) = w; }
        }
    }
}

DI void transpose_item(const float* W, int N, bf16* WT, int K, int k0, int n0, int R0, float* scr, int lane) {
#pragma unroll 8
    for (int i = 0; i < 32; ++i) { const int kk = 2 * i + (lane >> 5); scr[kk * 33 + (lane & 31)] = W[(size_t)(k0 + kk) * N + n0 + (lane & 31)]; }
    LDS_WAIT();
    const int cc = lane & 7;
#pragma unroll
    for (int j = 0; j < 4; ++j) { const int n = (lane >> 3) + 8 * j; const float* s = scr + (8 * cc) * 33 + n;
        u32x4 o; o.x = pk2(s[0 * 33], s[1 * 33]); o.y = pk2(s[2 * 33], s[3 * 33]); o.z = pk2(s[4 * 33], s[5 * 33]); o.w = pk2(s[6 * 33], s[7 * 33]);
        *(u32x4*)(WT + (size_t)(R0 + n) * K + k0 + 8 * cc) = o; }
    LDS_WAIT();
}
DI void convert_weights(const Params& p, const Ctx& c) {
    float* scr = (float*)(c.lds + c.wave * 16384);
    const int gw = c.bid * 8 + c.wave, NGW = c.G * 8;
    constexpr int I_IN = 16 * 104, I_OUT = 16 * 32, NITEMS = 2 * (I_IN + I_OUT);
    for (int it = gw; it < NITEMS; it += NGW) {
        int r = it; const int l = r / (I_IN + I_OUT); r -= l * (I_IN + I_OUT);
        if (r < I_IN) { const int kb = r / 104, nb = r % 104, n0 = 32 * nb, pn = n0 >> 8, within = n0 & 255, wc = within >> 6, bj = (within >> 5) & 1;
            transpose_item(p.in[I_WIN] + (size_t)l * 1024 * NIN, NIN, (bf16*)(p.ws + WS_WIN) + (size_t)l * NIN * 1024, 1024, 64 * kb, n0, 256 * pn + 128 * bj + 32 * wc, scr, c.lane);
        } else { r -= I_IN; const int kb = r / 32, nb = r % 32;
            transpose_item(p.in[I_WOUT] + (size_t)l * 1024 * 1024, 1024, (bf16*)(p.ws + WS_WOUT) + (size_t)l * 1024 * 1024, 1024, 64 * kb, 32 * nb, 32 * nb, scr, c.lane); }
    }
    bf16* wg = (bf16*)(p.ws + WS_WG);
    for (int i = c.bid * NTHREADS + c.tid; i < 2 * 2 * 2 * 4 * 4096; i += c.G * NTHREADS) {
        const int cc = i & 63, d = (i >> 6) & 63, n = (i >> 12) & 3, gate = (i >> 14) & 1, dir = (i >> 15) & 1, l = i >> 16;
        const float v = (gate ? p.in[I_WX] : p.in[I_WA])[(size_t)(((l * 2 + dir) * 4 + n) * 64 + cc) * 64 + d];
        wg[i] = (bf16)(pk2(v, 0.f) & 0xffffu);
    }
}
DI void convert_caches(const Params& p, const Ctx& c, int l) {
    const int gt = c.bid * NTHREADS + c.tid, NGT = c.G * NTHREADS;
    {
        const float* src = p.in[I_CGK]; bf16* dst = (bf16*)(p.ws + WS_KGL);
        for (int i = gt; i < 8 * 2 * 512 * 16; i += NGT) { const int d4 = i & 15, key = (i >> 4) & 511, kvh = (i >> 13) & 1, b = i >> 14;
            const f32x4 v = *(const f32x4*)(src + ((size_t)(b * 2 + l) * 512 + key) * 128 + kvh * 64 + 4 * d4);
            u32x2 w; w.x = pk2(v[0], v[1]); w.y = pk2(v[2], v[3]); *(u32x2*)(dst + ((size_t)(b * 2 + kvh) * 1536 + key) * 64 + 4 * d4) = w; }
    }
    {
        const float* src = p.in[I_CDK]; bf16* dst = (bf16*)(p.ws + WS_KDL);
        for (int i = gt; i < 8 * 8 * 512 * 16; i += NGT) { const int d4 = i & 15, key = (i >> 4) & 511, idx = (i >> 13) & 7, b = i >> 16;
            const f32x4 v = *(const f32x4*)(src + ((size_t)(b * 2 + l) * 512 + key) * 512 + idx * 64 + 4 * d4);
            u32x2 w; w.x = pk2(v[0], v[1]); w.y = pk2(v[2], v[3]); *(u32x2*)(dst + ((size_t)(b * 8 + idx) * 1536 + key) * 64 + 4 * d4) = w; }
    }
    {
        const float* src = p.in[I_CGV]; bf16* dst = (bf16*)(p.ws + WS_VGL);
        for (int i = gt; i < 8 * 2 * 128 * 64; i += NGT) { const int dv = i & 63, k4 = (i >> 6) & 127, kvh = (i >> 13) & 1, b = i >> 14;
            const float* s = src + ((size_t)(b * 2 + l) * 512 + 4 * k4) * 128 + kvh * 64 + dv;
            u32x2 w; w.x = pk2(s[0], s[128]); w.y = pk2(s[256], s[384]); *(u32x2*)(dst + ((size_t)(b * 2 + kvh) * 64 + dv) * 1536 + 4 * k4) = w; }
    }
    {
        const float* src = p.in[I_CDV]; bf16* dst = (bf16*)(p.ws + WS_VDL);
        for (int i = gt; i < 8 * 4 * 128 * 128; i += NGT) { const int dv = i & 127, k4 = (i >> 7) & 127, h = (i >> 14) & 3, b = i >> 16;
            const float* s = src + ((size_t)(b * 2 + l) * 512 + 4 * k4) * 512 + h * 128 + dv;
            u32x2 w; w.x = pk2(s[0], s[512]); w.y = pk2(s[1024], s[1536]); *(u32x2*)(dst + ((size_t)(b * 4 + h) * 128 + dv) * 1536 + 4 * k4) = w; }
    }
}

DI void phase_lru_gates(const Params& p, const Ctx& c, int l) {
    float* U = (float*)(c.lds + c.wave * 8704);
    const int n = c.wave & 3, dir = c.wave >> 2, r = c.lane & 31, h = c.lane >> 5;
    const bf16* wg = (const bf16*)(p.ws + WS_WG) + (size_t)(((l * 2 + dir) * 2) * 4 + n) * 4096;
    bf16x8 Bf[2][2][4];
#pragma unroll
    for (int g2 = 0; g2 < 2; ++g2)
#pragma unroll
        for (int dt = 0; dt < 2; ++dt)
#pragma unroll
            for (int ks = 0; ks < 4; ++ks) Bf[g2][dt][ks] = *(const bf16x8*)(wg + (size_t)g2 * 4 * 4096 + (32 * dt + r) * 64 + 16 * ks + 8 * h);
    float ba[2], bx[2], cd[2];
#pragma unroll
    for (int dt = 0; dt < 2; ++dt) { const int ch = (l * 2 + dir) * 256 + 64 * n + 32 * dt + r;
        ba[dt] = p.in[I_BA][ch]; bx[dt] = p.in[I_BX][ch]; cd[dt] = -8.0f * log1pf(expf(-p.in[I_LAM][ch])); }
    const int chl = 64 * n + c.lane;
    const float w0 = p.in[I_CONVW][(l * 4 + 0) * 256 + chl], w1 = p.in[I_CONVW][(l * 4 + 1) * 256 + chl], w2 = p.in[I_CONVW][(l * 4 + 2) * 256 + chl], w3 = p.in[I_CONVW][(l * 4 + 3) * 256 + chl];
    const float cb = p.in[I_CONVB][l * 256 + chl];
    const float* LX = (const float*)(p.ws + WS_LX);
    float* Ab = (float*)(p.ws + WS_R1) + (size_t)dir * NTOK * 256;
    float* Xb = (float*)(p.ws + WS_R1) + (size_t)(2 + dir) * NTOK * 256;
    for (int tile = c.bid; tile < 512; tile += c.G) {
        const int tok0 = tile * 32;
        int seq0, T;
        if (tok0 < NCTX) { seq0 = tok0 & ~255; T = 256; } else { seq0 = NCTX + ((tok0 - NCTX) & ~1023); T = 1024; }
        const int t0 = tok0 - seq0;
        float xw[35];
#pragma unroll
        for (int i = 0; i < 35; ++i) { const int t = t0 - 2 + i; xw[i] = (t >= 0 && t < T) ? LX[(size_t)(seq0 + t) * 256 + chl] : 0.f; }
#pragma unroll
        for (int tt = 0; tt < 32; ++tt) U[tt * 68 + c.lane] = cb + w0 * xw[tt] + w1 * xw[tt + 1] + w2 * xw[tt + 2] + w3 * xw[tt + 3];
        LDS_WAIT();
        bf16x8 Af[4];
#pragma unroll
        for (int ks = 0; ks < 4; ++ks) { const f32x4 a0 = *(const f32x4*)(U + r * 68 + 16 * ks + 8 * h), a1 = *(const f32x4*)(U + r * 68 + 16 * ks + 8 * h + 4);
            u32x4 w; w.x = pk2(a0[0], a0[1]); w.y = pk2(a0[2], a0[3]); w.z = pk2(a1[0], a1[1]); w.w = pk2(a1[2], a1[3]); Af[ks] = __builtin_bit_cast(bf16x8, w); }
        f32x16 acc[2][2];
#pragma unroll
        for (int g2 = 0; g2 < 2; ++g2)
#pragma unroll
            for (int dt = 0; dt < 2; ++dt) {
#pragma unroll
                for (int i = 0; i < 16; ++i) acc[g2][dt][i] = 0.f;
#pragma unroll
                for (int ks = 0; ks < 4; ++ks) acc[g2][dt] = MFMA32(Af[ks], Bf[g2][dt][ks], acc[g2][dt]);
            }
#pragma unroll
        for (int dt = 0; dt < 2; ++dt)
#pragma unroll
            for (int i = 0; i < 16; ++i) {
                const int tt = (i & 3) + 8 * (i >> 2) + 4 * h, d = 32 * dt + r;
                const float uu = U[tt * 68 + d];
                const float rr = sigm_f(acc[0][dt][i] + ba[dt]), ii = sigm_f(acc[1][dt][i] + bx[dt]);
                const float la = rr * cd[dt];
                const float a = __expf(la), om = -expm1f(2.0f * la);
                const size_t o = (size_t)(tok0 + tt) * 256 + 64 * n + d;
                Ab[o] = a; Xb[o] = sqrtf(om) * ii * uu;
            }
        LDS_WAIT();
    }
}

DI void scan_unit(const Params& p, const Ctx& c, int l, int sidx) {
    const bool lat = sidx < 8; const int b = lat ? sidx : sidx - 8, T = lat ? 1024 : 256, tok0 = lat ? NCTX + b * 1024 : b * 256;
    const int n = c.wave & 3, dir = c.wave >> 2, ch = 64 * n + c.lane;
    const float* __restrict__ A = (const float*)(p.ws + WS_R1) + (size_t)dir * NTOK * 256 + (size_t)tok0 * 256 + ch;
    const float* __restrict__ X = (const float*)(p.ws + WS_R1) + (size_t)(2 + dir) * NTOK * 256 + (size_t)tok0 * 256 + ch;
    float* __restrict__ Yo = (float*)(p.ws + (dir ? WS_YB : WS_YF)) + (size_t)tok0 * 256 + ch;
    float hst = lat ? p.in[I_SLRU][((b * 2 + l) * 2 + dir) * 256 + ch] : 0.f;
    float a0[8], x0[8], a1[8], x1[8];
    const int nb = T / 8;
#define SCAN_T(k) (dir ? (T - 1 - (k)) : (k))
#pragma unroll
    for (int i = 0; i < 8; ++i) { const int t = SCAN_T(i); a0[i] = A[(size_t)t * 256]; x0[i] = X[(size_t)t * 256]; }
    for (int blk = 0; blk < nb; blk += 2) {
#pragma unroll
        for (int i = 0; i < 8; ++i) { const int t = SCAN_T((blk + 1) * 8 + i); a1[i] = A[(size_t)t * 256]; x1[i] = X[(size_t)t * 256]; }
#pragma unroll
        for (int i = 0; i < 8; ++i) { const int t = SCAN_T(blk * 8 + i); hst = a0[i] * hst + x0[i]; Yo[(size_t)t * 256] = hst; }
        if (blk + 2 < nb) {
#pragma unroll
            for (int i = 0; i < 8; ++i) { const int t = SCAN_T((blk + 2) * 8 + i); a0[i] = A[(size_t)t * 256]; x0[i] = X[(size_t)t * 256]; }
        }
#pragma unroll
        for (int i = 0; i < 8; ++i) { const int t = SCAN_T((blk + 1) * 8 + i); hst = a1[i] * hst + x1[i]; Yo[(size_t)t * 256] = hst; }
    }
#undef SCAN_T
    if (!lat) p.out[OUT_LRU + (size_t)((b * 2 + l) * 2 + dir) * 256 + ch] = hst;
    VM_WAIT();
    __builtin_amdgcn_fence(__ATOMIC_RELEASE, "workgroup");
    __syncthreads();
    __builtin_amdgcn_fence(__ATOMIC_ACQUIRE, "agent");
    const float* YF = (const float*)(p.ws + WS_YF); const float* YB = (const float*)(p.ws + WS_YB);
    const bf16* GS = (const bf16*)(p.ws + WS_GS); bf16* MIX = (bf16*)(p.ws + WS_HM);
    for (int i = c.tid; i < T * 64; i += NTHREADS) { const int tok = tok0 + (i >> 6), c4 = (i & 63) * 4;
        const f32x4 yf = *(const f32x4*)(YF + (size_t)tok * 256 + c4), yb = *(const f32x4*)(YB + (size_t)tok * 256 + c4);
        const u32x2 g = *(const u32x2*)(GS + (size_t)tok * 1024 + c4);
        u32x2 w; w.x = pk2((yf[0] + yb[0]) * bflo(g.x), (yf[1] + yb[1]) * bfhi(g.x)); w.y = pk2((yf[2] + yb[2]) * bflo(g.y), (yf[3] + yb[3]) * bfhi(g.y));
        *(u32x2*)(MIX + (size_t)tok * 1024 + c4) = w; }
}

constexpr int AT_KB = 9216, AT_VOFF = 18432, AT_BUF = 36864;
template <int DV>
DI void attn_unit(const Params& p, const Ctx& c, int l, bool lat, int b, int hd, int qb) {
    constexpr int NK = DV == 128 ? 2 : 1, NV = DV / 64, NDT = DV / 32;
    const int Tk = lat ? LAT_TK : CTX_T;
    const int tokb = lat ? NCTX + b * LAT_T + qb * 128 : b * CTX_T + qb * 128;
    const int side = c.wave >> 2, wq = c.wave & 3, r = c.lane & 31, h = c.lane >> 5;
    const int tok = tokb + 32 * wq + r;
    const bf16* Qp = DV == 64 ? (const bf16*)(p.ws + WS_QG) + (size_t)tok * 256 + 64 * (2 * hd + side) : (const bf16*)(p.ws + WS_QD) + (size_t)tok * 512 + 64 * (2 * hd + side);
    const bf16* Kb[NK];
    const bf16* Vb;
    if (DV == 64) { Kb[0] = lat ? (const bf16*)(p.ws + WS_KGL) + (size_t)(b * 2 + hd) * 1536 * 64 : (const bf16*)(p.ws + WS_KGC) + (size_t)(b * 2 + hd) * 256 * 64;
        Vb = lat ? (const bf16*)(p.ws + WS_VGL) + (size_t)(b * 2 + hd) * 64 * 1536 : (const bf16*)(p.ws + WS_VGC) + (size_t)(b * 2 + hd) * 64 * 256; }
    else {
#pragma unroll
        for (int s = 0; s < NK; ++s) Kb[s] = lat ? (const bf16*)(p.ws + WS_KDL) + (size_t)(b * 8 + 2 * hd + s) * 1536 * 64 : (const bf16*)(p.ws + WS_KDC) + (size_t)(b * 8 + 2 * hd + s) * 256 * 64;
        Vb = lat ? (const bf16*)(p.ws + WS_VDL) + (size_t)(b * 4 + hd) * 128 * 1536 : (const bf16*)(p.ws + WS_VDC) + (size_t)(b * 4 + hd) * 128 * 256; }
    bf16x8 qf[4];
#pragma unroll
    for (int ks = 0; ks < 4; ++ks) qf[ks] = *(const bf16x8*)(Qp + 16 * ks + 8 * h);
    const int srow = c.tid >> 3, sch = c.tid & 7;
    u32x4 kreg[NK], vreg[NV];
    unsigned char* lds = c.lds;
#define STAGE_LOAD(k0_) do { const int k0__ = (k0_); \
        _Pragma("unroll") for (int s_ = 0; s_ < NK; ++s_) kreg[s_] = *(const u32x4*)(Kb[s_] + (size_t)(k0__ + srow) * 64 + 8 * sch); \
        _Pragma("unroll") for (int v_ = 0; v_ < NV; ++v_) vreg[v_] = *(const u32x4*)(Vb + (size_t)(srow + 64 * v_) * Tk + k0__ + 8 * sch); } while (0)
#define STAGE_WRITE(buf_) do { unsigned char* B_ = lds + (buf_) * AT_BUF; \
        _Pragma("unroll") for (int s_ = 0; s_ < NK; ++s_) *(u32x4*)(B_ + s_ * AT_KB + srow * 144 + sch * 16) = kreg[s_]; \
        _Pragma("unroll") for (int v_ = 0; v_ < NV; ++v_) { unsigned char* d_ = B_ + AT_VOFF + (srow + 64 * v_) * 136 + sch * 16; \
            u32x2 lo_, hi_; lo_.x = vreg[v_].x; lo_.y = vreg[v_].y; hi_.x = vreg[v_].z; hi_.y = vreg[v_].w; *(u32x2*)d_ = lo_; *(u32x2*)(d_ + 8) = hi_; } } while (0)
    f32x16 o[NDT];
#pragma unroll
    for (int dt = 0; dt < NDT; ++dt)
#pragma unroll
        for (int i = 0; i < 16; ++i) o[dt][i] = 0.f;
    float mrun = -INFINITY, lrun = 0.f;
    const int nt = Tk / 64;
    STAGE_LOAD(0); STAGE_WRITE(0);
    __syncthreads();
    for (int j = 0; j < nt; ++j) {
        if (j + 1 < nt) STAGE_LOAD((j + 1) * 64);
        const unsigned char* B = lds + (j & 1) * AT_BUF;
        const unsigned char* Kt = B + (DV == 128 ? side * AT_KB : 0);
        const unsigned char* Vt = B + AT_VOFF;
        f32x16 s[2];
#pragma unroll
        for (int kb = 0; kb < 2; ++kb) {
#pragma unroll
            for (int i = 0; i < 16; ++i) s[kb][i] = 0.f;
#pragma unroll
            for (int ks = 0; ks < 4; ++ks) { const bf16x8 kf = *(const bf16x8*)(Kt + (32 * kb + r) * 144 + (16 * ks + 8 * h) * 2); s[kb] = MFMA32(kf, qf[ks], s[kb]); }
        }
        float mx = s[0][0];
#pragma unroll
        for (int i = 1; i < 16; ++i) mx = fmaxf(mx, s[0][i]);
#pragma unroll
        for (int i = 0; i < 16; ++i) mx = fmaxf(mx, s[1][i]);
        mx = fmaxf(mx, __shfl_xor(mx, 32));
        const float mnew = fmaxf(mrun, mx), alpha = __builtin_amdgcn_exp2f(mrun - mnew);
        mrun = mnew;
        float ls = 0.f;
#pragma unroll
        for (int kb = 0; kb < 2; ++kb)
#pragma unroll
            for (int i = 0; i < 16; ++i) { const float e = __builtin_amdgcn_exp2f(s[kb][i] - mnew); s[kb][i] = e; ls += e; }
        lrun = lrun * alpha + ls;
#pragma unroll
        for (int dt = 0; dt < NDT; ++dt)
#pragma unroll
            for (int i = 0; i < 16; ++i) o[dt][i] *= alpha;
#pragma unroll
        for (int kb = 0; kb < 2; ++kb)
#pragma unroll
            for (int s2 = 0; s2 < 2; ++s2) {
                u32x4 pw; pw.x = pk2(s[kb][8 * s2 + 0], s[kb][8 * s2 + 1]); pw.y = pk2(s[kb][8 * s2 + 2], s[kb][8 * s2 + 3]); pw.z = pk2(s[kb][8 * s2 + 4], s[kb][8 * s2 + 5]); pw.w = pk2(s[kb][8 * s2 + 6], s[kb][8 * s2 + 7]);
                const bf16x8 pf = __builtin_bit_cast(bf16x8, pw);
#pragma unroll
                for (int dt = 0; dt < NDT; ++dt) { const unsigned char* va = Vt + (32 * dt + r) * 136 + (32 * kb + 16 * s2 + 4 * h) * 2;
                    const s16x4 lo = *(const s16x4*)va, hi = *(const s16x4*)(va + 16);
                    const bf16x8 vf = __builtin_shufflevector(lo, hi, 0, 1, 2, 3, 4, 5, 6, 7);
                    o[dt] = MFMA32(vf, pf, o[dt]); }
            }
        if (j + 1 < nt) STAGE_WRITE((j + 1) & 1);
        __syncthreads();
    }
    const float ltot = lrun + __shfl_xor(lrun, 32), inv = 1.0f / ltot;
#pragma unroll
    for (int dt = 0; dt < NDT; ++dt)
#pragma unroll
        for (int i = 0; i < 16; ++i) o[dt][i] *= inv;
    const bf16* GS = (const bf16*)(p.ws + WS_GS); bf16* MIX = (bf16*)(p.ws + WS_HM);
    if (DV == 64) {
        const int colb = 256 + 64 * (2 * hd + side);
#pragma unroll
        for (int dt = 0; dt < NDT; ++dt)
#pragma unroll
            for (int g4 = 0; g4 < 4; ++g4) { const int col = colb + 32 * dt + 8 * g4 + 4 * h;
                const u32x2 g = *(const u32x2*)(GS + (size_t)tok * 1024 + col);
                u32x2 w; w.x = pk2(o[dt][4 * g4] * bflo(g.x), o[dt][4 * g4 + 1] * bfhi(g.x)); w.y = pk2(o[dt][4 * g4 + 2] * bflo(g.y), o[dt][4 * g4 + 3] * bfhi(g.y));
                *(u32x2*)(MIX + (size_t)tok * 1024 + col) = w; }
    } else {
        float* Xc = (float*)lds;
        if (side == 1) {
#pragma unroll
            for (int dt = 0; dt < NDT; ++dt)
#pragma unroll
                for (int i = 0; i < 16; ++i) Xc[((wq * NDT + dt) * 16 + i) * 64 + c.lane] = o[dt][i];
        }
        __syncthreads();
        if (side == 0) {
            const float lam = ((const float*)(p.ws + WS_MISC))[l];
            const float oml = l == 0 ? 0.8f : (1.0f - 0.35550906759096934f);
            float ss = 0.f;
#pragma unroll
            for (int dt = 0; dt < NDT; ++dt)
#pragma unroll
                for (int i = 0; i < 16; ++i) { const float v = o[dt][i] - lam * Xc[((wq * NDT + dt) * 16 + i) * 64 + c.lane]; o[dt][i] = v; ss += v * v; }
            ss += __shfl_xor(ss, 32);
            const float rs = oml / sqrtf(ss * (1.0f / 128.0f) + EPS);
            const float* gsub = p.in[I_GSUB] + l * 128;
#pragma unroll
            for (int dt = 0; dt < NDT; ++dt)
#pragma unroll
                for (int g4 = 0; g4 < 4; ++g4) { const int dv = 32 * dt + 8 * g4 + 4 * h, col = 512 + 128 * hd + dv;
                    const u32x2 g = *(const u32x2*)(GS + (size_t)tok * 1024 + col); const f32x4 gb = *(const f32x4*)(gsub + dv);
                    u32x2 w; w.x = pk2(o[dt][4 * g4] * rs * gb[0] * bflo(g.x), o[dt][4 * g4 + 1] * rs * gb[1] * bfhi(g.x)); w.y = pk2(o[dt][4 * g4 + 2] * rs * gb[2] * bflo(g.y), o[dt][4 * g4 + 3] * rs * gb[3] * bfhi(g.y));
                    *(u32x2*)(MIX + (size_t)tok * 1024 + col) = w; }
        }
        __syncthreads();
    }
}

#undef STAGE_LOAD
#undef STAGE_WRITE
constexpr int Q_SCAN = 40, Q_LD = Q_SCAN + 256, Q_LG = Q_LD + 128, Q_CD = Q_LG + 256, Q_CG = Q_CD + 128;
DI void phase_queue(const Params& p, const Ctx& c, int l) {
    unsigned* head = (unsigned*)(p.ws + WS_CTL) + CW_QUEUE + 64 * l;
    volatile LAS unsigned* bc = (volatile LAS unsigned*)((LAS unsigned char*)c.lds + LDS_CTRL + 64);
    for (;;) {
        if (c.tid == 0) *bc = __hip_atomic_fetch_add(head, 1u, __ATOMIC_RELAXED, __HIP_MEMORY_SCOPE_AGENT);
        __syncthreads();
        const int u = (int)*bc;
        __syncthreads();
        if (u >= Q_CG) break;
        if (u < Q_SCAN) scan_unit(p, c, l, u);
        else if (u < Q_LD) { const int i = u - Q_SCAN; attn_unit<128>(p, c, l, true, i >> 5, (i >> 3) & 3, i & 7); }
        else if (u < Q_LG) { const int i = u - Q_LD; attn_unit<64>(p, c, l, true, i >> 4, (i >> 3) & 1, i & 7); }
        else if (u < Q_CD) { const int i = u - Q_LG; attn_unit<128>(p, c, l, false, i >> 3, (i >> 1) & 3, i & 1); }
        else { const int i = u - Q_CD; attn_unit<64>(p, c, l, false, i >> 2, (i >> 1) & 1, i & 1); }
    }
}

constexpr int N_PHASES = 12;
#ifndef MK_SPLIT
#define MK_SPLIT 0
#endif
__global__ void __launch_bounds__(NTHREADS, 2) hybrid_fwd(Params p) {
    __shared__ __attribute__((aligned(16))) unsigned char smem[LDS_BYTES];
    Ctx c; c.tid = threadIdx.x; c.lane = c.tid & 63; c.wave = __builtin_amdgcn_readfirstlane(c.tid >> 6); c.G = gridDim.x; c.bid = blockIdx.x; c.lds = smem;
    LAS unsigned char* lds3 = (LAS unsigned char*)smem;
    if (c.tid < 64) ((LAS unsigned*)(lds3 + LDS_CTRL))[c.tid] = 0u;
    __syncthreads();
    unsigned* ctl = (unsigned*)(p.ws + WS_CTL);
    XcdBarrier bar; bar.bar = ctl + CW_BAR; bar.x = 0; bar.st = nullptr;
    if (p.ph_hi - p.ph_lo > 1) bar = xcd_barrier_post(ctl + CW_BAR, (volatile LAS unsigned*)(lds3 + LDS_CTRL));
#define IN(k) (p.ph_lo <= (k) && (k) < p.ph_hi)
#define SEAM(k) do { if (IN(k) && IN((k) + 1)) xcd_barrier(bar); } while (0)
    if (IN(0)) phase_mod(p, c);
    SEAM(0);
    if (IN(1)) { rows_pass(p, c, -1, 0); convert_weights(p, c); convert_caches(p, c, 0); }
    SEAM(1);
#define LAYER(l, base) \
    if (IN(base)) { \
        pg8::Gemm g{(const pg8::bf16_t*)(p.ws + WS_HM), (const pg8::bf16_t*)(p.ws + WS_WIN) + (size_t)(l) * NIN * 1024, NTOK, NIN, 1024}; \
        pg8::StaticOrder S; S.init(NTOK, NIN, c.G, c.bid); \
        pg8::EpiIn E{l, p.out, p.ws, p.in[I_GQ] + (l) * 64, p.in[I_GK] + (l) * 64}; \
        pg8::gemm_phase<pg8::EpiIn, pg8::StaticOrder, true, true>(lds3, g, S, E); } \
    SEAM(base); \
    if (IN(base + 1)) phase_lru_gates(p, c, l); \
    SEAM(base + 1); \
    if (IN(base + 2)) phase_queue(p, c, l); \
    SEAM(base + 2); \
    if (IN(base + 3)) { \
        pg8::Gemm g{(const pg8::bf16_t*)(p.ws + WS_HM), (const pg8::bf16_t*)(p.ws + WS_WOUT) + (size_t)(l) * 1024 * 1024, NTOK, 1024, 1024}; \
        pg8::StaticOrder S; S.init(NTOK, 1024, c.G, c.bid); \
        pg8::EpiY E{(float*)(p.ws + WS_R1)}; \
        pg8::gemm_phase<pg8::EpiY, pg8::StaticOrder, true, true>(lds3, g, S, E); } \
    SEAM(base + 3); \
    if (IN(base + 4)) { rows_pass(p, c, l, (l) == 0 ? 1 : -1); if ((l) == 0) convert_caches(p, c, 1); } \
    SEAM(base + 4);
    LAYER(0, 2)
    LAYER(1, 7)
#undef LAYER
#undef SEAM
#undef IN
}

extern "C" void kernel_launch(void* const* d_in, const int* in_sizes, int n_in, void* d_out, int out_size, void* d_ws, size_t ws_size, hipStream_t stream) {
    static int grid = 0;
    if (grid == 0) {
        if (n_in != 26 || ws_size < WS_END) { fprintf(stderr, "kernel_launch: expected 26 inputs and >= %zu bytes of workspace (got %d, %zu); nothing launched\n", (size_t)WS_END, n_in, ws_size); grid = -1; return; }
        int dev = 0, cus = 0, per_cu = 0;
        if (hipGetDevice(&dev) != hipSuccess || hipDeviceGetAttribute(&cus, hipDeviceAttributeMultiprocessorCount, dev) != hipSuccess) { grid = -1; return; }
        if (false) { fprintf(stderr, "kernel_launch: hipFuncSetAttribute failed\n"); grid = -1; return; }
        if (hipOccupancyMaxActiveBlocksPerMultiprocessor(&per_cu, (const void*)hybrid_fwd, NTHREADS, 0) != hipSuccess || per_cu < 1) { fprintf(stderr, "kernel_launch: occupancy query says %d workgroups per CU; nothing launched\n", per_cu); (void)hipGetLastError(); grid = -1; return; }
        grid = cus;
    }
    if (grid < 0) return;
    (void)hipMemsetAsync((char*)d_ws + WS_CTL, 0, CTL_BYTES, stream);
    Params p{};
    for (int i = 0; i < 26; ++i) p.in[i] = (const float*)d_in[i];
    p.out = (float*)d_out; p.ws = (unsigned char*)d_ws;
#if MK_SPLIT
    for (int ph = 0; ph < N_PHASES; ++ph) { p.ph_lo = ph; p.ph_hi = ph + 1; hipLaunchKernelGGL(hybrid_fwd, dim3(grid), dim3(NTHREADS), 0, stream, p); }
#else
    p.ph_lo = 0; p.ph_hi = N_PHASES;
    hipLaunchKernelGGL(hybrid_fwd, dim3(grid), dim3(NTHREADS), 0, stream, p);
#endif
}
```

```cpp
#include <hip/hip_runtime.h>
#include <cstdio>
#include <cstdint>

#define DI __device__ __forceinline__
#define LAS __attribute__((address_space(3)))
typedef unsigned short bf16;
typedef short bf16x8 __attribute__((ext_vector_type(8)));
typedef short s16x4 __attribute__((ext_vector_type(4)));
typedef float f32x2 __attribute__((ext_vector_type(2)));
typedef float f32x4 __attribute__((ext_vector_type(4)));
typedef float f32x16 __attribute__((ext_vector_type(16)));
typedef unsigned u32x2 __attribute__((ext_vector_type(2)));
typedef unsigned u32x4 __attribute__((ext_vector_type(4)));

constexpr int DM = 1024, NIN = 3328, NTOK = 16384, NCTX = 8192;
constexpr int CTX_T = 256, LAT_T = 1024, LAT_TK = 1536;
constexpr float EPS = 1e-6f;
constexpr float QSCALE = 0.18033688011112042f;
constexpr int NTHREADS = 512;

constexpr size_t MiB = 1u << 20;
constexpr size_t WS_CTL = 0, CTL_BYTES = 64 * 1024;
constexpr size_t WS_MOD = 1 * MiB;
constexpr size_t WS_ROPE = 1 * MiB + 256 * 1024;
constexpr size_t WS_MISC = 1 * MiB + 320 * 1024;
constexpr size_t WS_WG = 1 * MiB + 512 * 1024;
constexpr size_t WS_WIN = 2 * MiB;
constexpr size_t WS_WOUT = 15 * MiB;
constexpr size_t WS_HM = 20 * MiB;
constexpr size_t WS_LX = 52 * MiB;
constexpr size_t WS_GS = 68 * MiB;
constexpr size_t WS_QG = 100 * MiB;
constexpr size_t WS_QD = 108 * MiB;
constexpr size_t WS_KGC = 124 * MiB;
constexpr size_t WS_VGC = 126 * MiB;
constexpr size_t WS_KDC = 128 * MiB;
constexpr size_t WS_VDC = 136 * MiB;
constexpr size_t WS_KGL = 144 * MiB;
constexpr size_t WS_VGL = 147 * MiB;
constexpr size_t WS_KDL = 150 * MiB;
constexpr size_t WS_VDL = 162 * MiB;
constexpr size_t WS_R1 = 174 * MiB;
constexpr size_t WS_YF = 238 * MiB;
constexpr size_t WS_YB = WS_LX;
constexpr size_t WS_END = 254 * MiB;
constexpr int CW_QUEUE = 64;
constexpr int CW_BAR = 1024;

constexpr size_t OUT_GK = 16777216, OUT_GV = 18874368, OUT_DK = 20971520, OUT_DV = 29360128, OUT_LRU = 37748736;

constexpr int LDS_BYTES = 147456;
constexpr int LDS_CTRL = LDS_BYTES - 1024;

DI unsigned pk2(float a, float b) {
    typedef __bf16 b2 __attribute__((ext_vector_type(2)));
    f32x2 v = {a, b};
    return __builtin_bit_cast(unsigned, __builtin_convertvector(v, b2));
}
DI float bflo(unsigned u) { return __uint_as_float(u << 16); }
DI float bfhi(unsigned u) { return __uint_as_float(u & 0xffff0000u); }
DI float silu_f(float x) { return x / (1.f + __expf(-x)); }
DI float sigm_f(float x) { return 1.f / (1.f + __expf(-x)); }
#define LDS_WAIT() asm volatile("s_waitcnt lgkmcnt(0)" ::: "memory")
#define VM_WAIT() asm volatile("s_waitcnt vmcnt(0)" ::: "memory")
#define MFMA32(a, b, c) __builtin_amdgcn_mfma_f32_32x32x16_bf16((a), (b), (c), 0, 0, 0)

struct Params {
    const float* in[26];
    float* out;
    unsigned char* ws;
    int ph_lo, ph_hi;
};
enum { I_XP = 0, I_XS, I_CGK, I_CGV, I_CDK, I_CDV, I_SLRU, I_C, I_CCTX, I_WMOD, I_BMOD, I_GPRE, I_GPOST, I_WIN, I_WOUT, I_CONVW, I_CONVB,
       I_WA, I_BA, I_WX, I_BX, I_LAM, I_GQ, I_GK, I_DLAM, I_GSUB };

namespace pg8 {
#define PG8_LAS __attribute__((address_space(3)))
typedef unsigned short bf16_t;
typedef short bf16x8 __attribute__((ext_vector_type(8)));
typedef float f32x4 __attribute__((ext_vector_type(4)));
typedef unsigned u32x4 __attribute__((ext_vector_type(4)));
constexpr int BM = 256, BK = 64, HALF = 128, HTB = HALF * BK * 2  , STAGE_BYTES = 8 * HTB, NXCD = 8, WGM = 8;

__host__ __device__ __forceinline__ int lds_byte(int r, int c) { const int st = (r >> 4) * 2 + (c >> 5), rr = r & 15, cc = c & 31, ob = rr * 64 + cc * 2; return st * 1024 + (ob ^ (((ob >> 9) & 1) << 5)); }
__host__ __device__ __forceinline__ void stage_rc(int b, int& R, int& C) { const int st = b / 1024, sb = b % 1024, swz = sb ^ (((sb >> 9) & 1) << 5); R = (st >> 1) * 16 + swz / 64; C = (st & 1) * 32 + (swz % 64) / 2; }
__host__ __device__ __forceinline__ int perm32(int rho) { const int n = rho >> 4, i = rho & 15; return 8 * (i >> 2) + 4 * n + (i & 3); }

struct Unit { int pm, pn; };
struct Gemm { const bf16_t* A; const bf16_t* Bt; int M, N, K; };

struct StaticOrder {
    int nM, nN, nwg, G, c;
    __host__ __device__ void init(int M, int N, int G_, int c_) { nM = M / BM; nN = N / BM; nwg = nM * nN; G = G_; c = c_; }
    __host__ __device__ bool next(int i, Unit& u) const {
        const long L = (long)i * G + c; if (L >= nwg) return false;
        int wgid = (int)L; { const int q = nwg / NXCD, r = nwg % NXCD, xcd = wgid % NXCD, off = wgid / NXCD; wgid = (xcd < r ? xcd * (q + 1) : r * (q + 1) + (xcd - r) * q) + off; }
        const int nig = WGM * nN, gid = wgid / nig, fm = gid * WGM, gsz = (nM - fm) < WGM ? (nM - fm) : WGM;
        u.pm = fm + ((wgid % nig) % gsz); u.pn = (wgid % nig) / gsz; return true;
    }
    __device__ __forceinline__ void a_ready(const Unit&) const {}
    __device__ __forceinline__ void done(const Unit&) const {}
};


struct EpiY {
    static constexpr bool PERM = false, AFTER_DRAIN = false;
    float* Y;
    __device__ __forceinline__ void operator()(const f32x4 (&acc)[2][2][4][2], const Unit& u, int wr, int wc, int fr_, int fq_) const {
        int fr = fr_, fq = fq_;
        asm volatile("" : "+v"(fr), "+v"(fq));
#pragma unroll
        for (int ai = 0; ai < 2; ++ai)
#pragma unroll
            for (int m = 0; m < 4; ++m) {
                float* rowp = Y + (size_t)(u.pm * BM + ai * HALF + wr * 64 + m * 16 + fr) * 1024 + u.pn * BM + wc * 32 + 4 * fq;
#pragma unroll
                for (int bj = 0; bj < 2; ++bj)
#pragma unroll
                    for (int n = 0; n < 2; ++n) *(f32x4*)(rowp + bj * HALF + n * 16) = acc[ai][bj][m][n];
            }
    }
};

struct EpiIn {
    static constexpr bool PERM = false, AFTER_DRAIN = false;
    int l;
    float* out;
    unsigned char* ws;
    const float* gq; const float* gk;
    __device__ __forceinline__ static void rope(f32x4 (&v)[2][2], const float* ropetab, int t, int fq) {
#pragma unroll
        for (int bj = 0; bj < 2; ++bj) {
            const int pos = bj == 0 ? (t >> 6) : (t & 63);
            const f32x4 cs0 = *(const f32x4*)(ropetab + (pos * 16 + 4 * fq) * 2), cs1 = *(const f32x4*)(ropetab + (pos * 16 + 4 * fq) * 2 + 4);
            const float c[4] = {cs0[0], cs0[2], cs1[0], cs1[2]}, s[4] = {cs0[1], cs0[3], cs1[1], cs1[3]};
#pragma unroll
            for (int e = 0; e < 4; ++e) { const float x1 = v[bj][0][e], x2 = v[bj][1][e]; v[bj][0][e] = x1 * c[e] - x2 * s[e]; v[bj][1][e] = x2 * c[e] + x1 * s[e]; }
        }
    }
    __device__ __forceinline__ static float headnorm(const f32x4 (&v)[2][2]) {
        float ss = 0.f;
#pragma unroll
        for (int bj = 0; bj < 2; ++bj)
#pragma unroll
            for (int n = 0; n < 2; ++n) ss += (v[bj][n][0] * v[bj][n][0] + v[bj][n][1] * v[bj][n][1]) + (v[bj][n][2] * v[bj][n][2] + v[bj][n][3] * v[bj][n][3]);
        ss += __shfl_xor(ss, 16); ss += __shfl_xor(ss, 32);
        return 1.0f / sqrtf(ss * (1.0f / 64.0f) + EPS);
    }
    __device__ __forceinline__ void operator()(const f32x4 (&acc)[2][2][4][2], const Unit& u, int wr, int wc, int fr_, int fq_) const {
        int fr = fr_, fq = fq_;
        asm volatile("" : "+v"(fr), "+v"(fq));
        const int g = 4 * u.pn + wc;
        const bool lat = u.pm >= 32;
        const int b = lat ? ((u.pm - 32) >> 2) : u.pm, tbase = lat ? ((u.pm - 32) & 3) * 256 : 0;
        const float* ropetab = (const float*)(ws + WS_ROPE);
        int kind, idx;
        if (g < 4) { kind = 0; idx = g; } else if (g < 8) { kind = 1; idx = 64 * (g - 4); } else if (g < 12) { kind = 2; idx = g - 8; } else if (g < 14) { kind = 3; idx = g - 12; }
        else if (g < 16) { kind = 4; idx = g - 14; } else if (g < 20) { kind = 1; idx = 256 + 64 * (g - 16); } else if (g < 28) { kind = 5; idx = g - 20; } else if (g < 36) { kind = 6; idx = g - 28; }
        else if (g < 44) { kind = 7; idx = g - 36; } else { kind = 1; idx = 512 + 64 * (g - 44); }
        float gw[2][2][4];
        if (kind == 2 || kind == 3) { const float* gsrc = kind == 2 ? gq : gk;
#pragma unroll
            for (int bj = 0; bj < 2; ++bj)
#pragma unroll
                for (int n = 0; n < 2; ++n) { const f32x4 t4 = *(const f32x4*)(gsrc + 32 * bj + 16 * n + 4 * fq); gw[bj][n][0] = t4[0]; gw[bj][n][1] = t4[1]; gw[bj][n][2] = t4[2]; gw[bj][n][3] = t4[3]; } }
#pragma unroll
        for (int ai = 0; ai < 2; ++ai)
#pragma unroll
            for (int m = 0; m < 4; ++m) {
                const int rt = ai * HALF + wr * 64 + m * 16 + fr, mrow = u.pm * BM + rt, t = tbase + rt;
                f32x4 v[2][2];
#pragma unroll
                for (int bj = 0; bj < 2; ++bj)
#pragma unroll
                    for (int n = 0; n < 2; ++n) v[bj][n] = acc[ai][bj][m][n];
                if (kind == 0) {
                    float* dst = (float*)(ws + WS_LX) + (size_t)mrow * 256 + 64 * idx + 4 * fq;
#pragma unroll
                    for (int bj = 0; bj < 2; ++bj)
#pragma unroll
                        for (int n = 0; n < 2; ++n) *(f32x4*)(dst + 32 * bj + 16 * n) = v[bj][n];
                } else if (kind == 1) {
                    bf16_t* dst = (bf16_t*)(ws + WS_GS) + (size_t)mrow * 1024 + idx + 4 * fq;
#pragma unroll
                    for (int bj = 0; bj < 2; ++bj)
#pragma unroll
                        for (int n = 0; n < 2; ++n) { u32x2 w; w.x = pk2(silu_f(v[bj][n][0]), silu_f(v[bj][n][1])); w.y = pk2(silu_f(v[bj][n][2]), silu_f(v[bj][n][3])); *(u32x2*)(dst + 32 * bj + 16 * n) = w; }
                } else if (kind == 2 || kind == 5) {
                    if (kind == 2) { const float rs = headnorm(v);
#pragma unroll
                        for (int bj = 0; bj < 2; ++bj)
#pragma unroll
                            for (int n = 0; n < 2; ++n)
#pragma unroll
                                for (int e = 0; e < 4; ++e) v[bj][n][e] *= rs * gw[bj][n][e]; }
                    if (lat) rope(v, ropetab, t, fq);
                    bf16_t* dst = (kind == 2 ? (bf16_t*)(ws + WS_QG) + (size_t)mrow * 256 : (bf16_t*)(ws + WS_QD) + (size_t)mrow * 512) + 64 * idx + 4 * fq;
#pragma unroll
                    for (int bj = 0; bj < 2; ++bj)
#pragma unroll
                        for (int n = 0; n < 2; ++n) { u32x2 w; w.x = pk2(v[bj][n][0] * QSCALE, v[bj][n][1] * QSCALE); w.y = pk2(v[bj][n][2] * QSCALE, v[bj][n][3] * QSCALE); *(u32x2*)(dst + 32 * bj + 16 * n) = w; }
                } else if (kind == 3 || kind == 6) {
                    if (kind == 3) { const float rs = headnorm(v);
#pragma unroll
                        for (int bj = 0; bj < 2; ++bj)
#pragma unroll
                            for (int n = 0; n < 2; ++n)
#pragma unroll
                                for (int e = 0; e < 4; ++e) v[bj][n][e] *= rs * gw[bj][n][e]; }
                    bf16_t* dst;
                    if (!lat) {
                        float* o = kind == 3 ? out + OUT_GK + ((size_t)(b * 2 + l) * 256 + t) * 128 + 64 * idx + 4 * fq : out + OUT_DK + ((size_t)(b * 2 + l) * 256 + t) * 512 + 64 * idx + 4 * fq;
#pragma unroll
                        for (int bj = 0; bj < 2; ++bj)
#pragma unroll
                            for (int n = 0; n < 2; ++n) *(f32x4*)(o + 32 * bj + 16 * n) = v[bj][n];
                        dst = kind == 3 ? (bf16_t*)(ws + WS_KGC) + ((size_t)(b * 2 + idx) * 256 + t) * 64 : (bf16_t*)(ws + WS_KDC) + ((size_t)(b * 8 + idx) * 256 + t) * 64;
                    } else {
                        rope(v, ropetab, t, fq);
                        dst = kind == 3 ? (bf16_t*)(ws + WS_KGL) + ((size_t)(b * 2 + idx) * 1536 + 512 + t) * 64 : (bf16_t*)(ws + WS_KDL) + ((size_t)(b * 8 + idx) * 1536 + 512 + t) * 64;
                    }
                    dst += 4 * fq;
#pragma unroll
                    for (int bj = 0; bj < 2; ++bj)
#pragma unroll
                        for (int n = 0; n < 2; ++n) { u32x2 w; w.x = pk2(v[bj][n][0], v[bj][n][1]); w.y = pk2(v[bj][n][2], v[bj][n][3]); *(u32x2*)(dst + 32 * bj + 16 * n) = w; }
                } else {
                    bf16_t* dst; int pitch, key;
                    if (!lat) {
                        float* o = kind == 4 ? out + OUT_GV + ((size_t)(b * 2 + l) * 256 + t) * 128 + 64 * idx + 4 * fq : out + OUT_DV + ((size_t)(b * 2 + l) * 256 + t) * 512 + 64 * idx + 4 * fq;
#pragma unroll
                        for (int bj = 0; bj < 2; ++bj)
#pragma unroll
                            for (int n = 0; n < 2; ++n) *(f32x4*)(o + 32 * bj + 16 * n) = v[bj][n];
                        pitch = 256; key = t;
                        dst = kind == 4 ? (bf16_t*)(ws + WS_VGC) + (size_t)(b * 2 + idx) * 64 * 256 : (bf16_t*)(ws + WS_VDC) + ((size_t)(b * 4 + (idx >> 1)) * 128 + 64 * (idx & 1)) * 256;
                    } else {
                        pitch = 1536; key = 512 + t;
                        dst = kind == 4 ? (bf16_t*)(ws + WS_VGL) + (size_t)(b * 2 + idx) * 64 * 1536 : (bf16_t*)(ws + WS_VDL) + ((size_t)(b * 4 + (idx >> 1)) * 128 + 64 * (idx & 1)) * 1536;
                    }
#pragma unroll
                    for (int bj = 0; bj < 2; ++bj)
#pragma unroll
                        for (int n = 0; n < 2; ++n) { const unsigned w0 = pk2(v[bj][n][0], v[bj][n][1]), w1 = pk2(v[bj][n][2], v[bj][n][3]);
                            bf16_t* d0 = dst + (size_t)(32 * bj + 16 * n + 4 * fq) * pitch + key;
                            d0[0] = (bf16_t)(w0 & 0xffffu); d0[pitch] = (bf16_t)(w0 >> 16); d0[2 * pitch] = (bf16_t)(w1 & 0xffffu); d0[3 * pitch] = (bf16_t)(w1 >> 16); }
                }
            }
    }
};
template <class Epi, class Sched, bool ALIGN_EPI = false, bool SP2 = false>
__device__ __forceinline__ void gemm_phase(PG8_LAS unsigned char* lds, const Gemm g, const Sched& S, const Epi& E) {
    const int tid = threadIdx.x, wid = __builtin_amdgcn_readfirstlane(tid >> 6), lane = tid & 63, wr = wid >> 2, wc = wid & 3, fr = lane & 15, fq = lane >> 4;
    const int K = g.K, nt = K / BK;
    unsigned voffA[2], voffB[2];
#pragma unroll
    for (int i = 0; i < 2; ++i) { int R, C; stage_rc(tid * 16 + i * 8192, R, C); const int Rb = Epi::PERM ? ((R & ~31) + perm32(R & 31)) : R;
        voffA[i] = (unsigned)(R * K + C) * 2u; voffB[i] = (unsigned)(Rb * K + C) * 2u; }
    const size_t kstep = (size_t)(BK * 2);
    const size_t hstep = (size_t)HALF * K * 2;
    const size_t tstep = 2 * hstep;
    const unsigned ldsw = (unsigned)wid * 1024u;
    const int aoff = lds_byte(wr * 64 + fr, fq * 8), boff = lds_byte(wc * 32 + fr, fq * 8);
#define PG8_SA(b, h) (((b) * 2 + (h)) * HTB)
#define PG8_SB(b, h) ((4 + (b) * 2 + (h)) * HTB)
#define PG8_STAGE(bufoff, gbase, voff) do { _Pragma("unroll") for (int _i = 0; _i < 2; ++_i) \
        __builtin_amdgcn_global_load_lds((const unsigned*)((const char*)(gbase) + (voff)[_i]), (PG8_LAS unsigned*)(lds + (bufoff) + ldsw + _i * 8192), 16, 0, 0); } while (0)
#define PG8_LDA(dst, b, h) do { _Pragma("unroll") for (int m = 0; m < 4; ++m) _Pragma("unroll") for (int k = 0; k < 2; ++k) dst[m][k] = *(const PG8_LAS bf16x8*)(lds + PG8_SA(b, h) + aoff + m * 2048 + k * 1024); } while (0)
#define PG8_LDB(dst, b, h) do { _Pragma("unroll") for (int n = 0; n < 2; ++n) _Pragma("unroll") for (int k = 0; k < 2; ++k) dst[n][k] = *(const PG8_LAS bf16x8*)(lds + PG8_SB(b, h) + boff + n * 2048 + k * 1024); } while (0)
#define PG8_MMA(ai, bj, At, Bt) do { __builtin_amdgcn_s_setprio(1); _Pragma("unroll") for (int m = 0; m < 4; ++m) _Pragma("unroll") for (int n = 0; n < 2; ++n) _Pragma("unroll") for (int k = 0; k < 2; ++k) \
        acc[ai][bj][m][n] = __builtin_amdgcn_mfma_f32_16x16x32_bf16(Bt[n][k], At[m][k], acc[ai][bj][m][n], 0, 0, 0); __builtin_amdgcn_s_setprio(0); } while (0)
#define PG8_WAIT_V(n) asm volatile("s_waitcnt vmcnt(" #n ")" ::: "memory")
#define PG8_WAIT_L(n) asm volatile("s_waitcnt lgkmcnt(" #n ")" ::: "memory")
#define PG8_BAR __builtin_amdgcn_s_barrier()
#define PG8_SCHED __builtin_amdgcn_sched_barrier(0)
    Unit cur, nxt; int ui = 0;
    if (!S.next(0, cur)) return;
    f32x4 acc[2][2][4][2];
#pragma unroll
    for (int a = 0; a < 2; ++a)
#pragma unroll
        for (int b = 0; b < 2; ++b)
#pragma unroll
            for (int m = 0; m < 4; ++m)
#pragma unroll
                for (int n = 0; n < 2; ++n) acc[a][b][m][n] = (f32x4){0.f, 0.f, 0.f, 0.f};
    bf16x8 At[4][2], B0[2][2], B1[2][2];
    const char* cA = (const char*)g.A + (size_t)cur.pm * tstep; const char* cB = (const char*)g.Bt + (size_t)cur.pn * tstep;
    S.a_ready(cur);
    if constexpr (SP2) {
        PG8_STAGE(PG8_SB(0, 0), cB, voffB); PG8_STAGE(PG8_SB(0, 1), cB + hstep, voffB); PG8_STAGE(PG8_SA(0, 0), cA, voffA); PG8_STAGE(PG8_SA(0, 1), cA + hstep, voffA);
        if (wr == 1) PG8_BAR;
        PG8_WAIT_V(2); PG8_BAR;
        PG8_STAGE(PG8_SB(1, 0), cB + kstep, voffB); PG8_STAGE(PG8_SA(1, 0), cA + kstep, voffA); PG8_STAGE(PG8_SB(1, 1), cB + hstep + kstep, voffB);
        PG8_WAIT_V(6); PG8_BAR;
    } else {
        PG8_STAGE(PG8_SB(0, 0), cB, voffB); PG8_STAGE(PG8_SA(0, 0), cA, voffA); PG8_STAGE(PG8_SB(0, 1), cB + hstep, voffB); PG8_STAGE(PG8_SA(0, 1), cA + hstep, voffA);
        if (wr == 1) PG8_BAR;
        PG8_WAIT_V(4); PG8_BAR;
        PG8_STAGE(PG8_SB(1, 0), cB + kstep, voffB); PG8_STAGE(PG8_SA(1, 0), cA + kstep, voffA); PG8_STAGE(PG8_SB(1, 1), cB + hstep + kstep, voffB);
        PG8_WAIT_V(6); PG8_BAR;
    }
    for (;;) {
        const bool has_next = S.next(ui + 1, nxt);
        const char* nA = has_next ? (const char*)g.A + (size_t)nxt.pm * tstep : cA; const char* nB = has_next ? (const char*)g.Bt + (size_t)nxt.pn * tstep : cB;
        for (int t = 0; t < nt; t += 2) {
            const bool last = (t == nt - 2);
            const char* a1 = cA + (size_t)(t + 1) * kstep;
            const char* a2 = last ? nA : cA + (size_t)(t + 2) * kstep; const char* b2 = last ? nB : cB + (size_t)(t + 2) * kstep;
            const char* a3 = a2 + kstep; const char* b3 = b2 + kstep;
            if (last && has_next) S.a_ready(nxt);
            if constexpr (SP2) {
            PG8_LDB(B0, 0, 0); PG8_LDB(B1, 0, 1); PG8_SCHED; PG8_LDA(At, 0, 0); PG8_STAGE(PG8_SA(1, 1), a1 + hstep, voffA);
            PG8_WAIT_V(8); PG8_WAIT_L(0); PG8_BAR; PG8_MMA(0, 0, At, B0); PG8_MMA(0, 1, At, B1); PG8_BAR; PG8_SCHED;
            PG8_LDA(At, 0, 1); PG8_STAGE(PG8_SB(0, 0), b2, voffB); PG8_STAGE(PG8_SB(0, 1), b2 + hstep, voffB); PG8_STAGE(PG8_SA(0, 0), a2, voffA);
            PG8_WAIT_V(8); PG8_WAIT_L(0); PG8_BAR; PG8_MMA(1, 0, At, B0); PG8_MMA(1, 1, At, B1); PG8_BAR; PG8_SCHED;
            PG8_LDB(B0, 1, 0); PG8_LDB(B1, 1, 1); PG8_SCHED; PG8_LDA(At, 1, 0); PG8_STAGE(PG8_SA(0, 1), a2 + hstep, voffA);
            PG8_WAIT_V(8); PG8_WAIT_L(0); PG8_BAR; PG8_MMA(0, 0, At, B0); PG8_MMA(0, 1, At, B1); PG8_BAR; PG8_SCHED;
            PG8_LDA(At, 1, 1); PG8_STAGE(PG8_SB(1, 0), b3, voffB); PG8_STAGE(PG8_SB(1, 1), b3 + hstep, voffB); PG8_STAGE(PG8_SA(1, 0), a3, voffA);
            PG8_WAIT_V(8); PG8_WAIT_L(0); PG8_BAR; PG8_MMA(1, 0, At, B0); PG8_MMA(1, 1, At, B1); PG8_BAR; PG8_SCHED;
            } else {
            PG8_LDB(B0, 0, 0); PG8_SCHED; PG8_LDA(At, 0, 0); PG8_STAGE(PG8_SA(1, 1), a1 + hstep, voffA);
            PG8_WAIT_L(8); PG8_BAR; PG8_WAIT_L(0); PG8_MMA(0, 0, At, B0); PG8_BAR; PG8_SCHED;
            PG8_LDB(B1, 0, 1); PG8_STAGE(PG8_SB(0, 0), b2, voffB);
            PG8_BAR; PG8_WAIT_L(0); PG8_MMA(0, 1, At, B1); PG8_BAR;
            PG8_LDA(At, 0, 1); PG8_STAGE(PG8_SA(0, 0), a2, voffA);
            PG8_BAR; PG8_WAIT_L(0); PG8_MMA(1, 0, At, B0); PG8_BAR; PG8_SCHED;
            PG8_STAGE(PG8_SB(0, 1), b2 + hstep, voffB);
            PG8_WAIT_V(6); PG8_BAR; PG8_MMA(1, 1, At, B1); PG8_BAR;
            PG8_LDB(B0, 1, 0); PG8_SCHED; PG8_LDA(At, 1, 0); PG8_STAGE(PG8_SA(0, 1), a2 + hstep, voffA);
            PG8_WAIT_L(8); PG8_BAR; PG8_WAIT_L(0); PG8_MMA(0, 0, At, B0); PG8_BAR; PG8_SCHED;
            PG8_LDB(B1, 1, 1); PG8_STAGE(PG8_SB(1, 0), b3, voffB);
            PG8_BAR; PG8_WAIT_L(0); PG8_MMA(0, 1, At, B1); PG8_BAR;
            PG8_LDA(At, 1, 1); PG8_STAGE(PG8_SA(1, 0), a3, voffA);
            PG8_BAR; PG8_WAIT_L(0); PG8_MMA(1, 0, At, B0); PG8_BAR; PG8_SCHED;
            PG8_STAGE(PG8_SB(1, 1), b3 + hstep, voffB);
            PG8_WAIT_V(6); PG8_BAR; PG8_MMA(1, 1, At, B1); PG8_BAR;
            }
        }
        if constexpr (ALIGN_EPI) { if (wr == 0) PG8_BAR; }
        if constexpr (!Epi::AFTER_DRAIN) { E(acc, cur, wr, wc, fr, fq); S.done(cur); }
        if (!has_next) break;
#pragma unroll
        for (int a = 0; a < 2; ++a)
#pragma unroll
            for (int b = 0; b < 2; ++b)
#pragma unroll
                for (int m = 0; m < 4; ++m)
#pragma unroll
                    for (int n = 0; n < 2; ++n) acc[a][b][m][n] = (f32x4){0.f, 0.f, 0.f, 0.f};
        cur = nxt; cA = nA; cB = nB; ++ui;
        if constexpr (ALIGN_EPI) { if (wr == 1) PG8_BAR; }
    }
    PG8_WAIT_V(0);
    if constexpr (!ALIGN_EPI) { if (wr == 0) PG8_BAR; }
    PG8_BAR;
    if constexpr (Epi::AFTER_DRAIN) { E.fused(acc, cur, wr, wc, fr, fq, lds, wid, lane); S.done(cur); }
#undef PG8_SA
#undef PG8_SB
#undef PG8_STAGE
#undef PG8_LDA
#undef PG8_LDB
#undef PG8_MMA
#undef PG8_WAIT_V
#undef PG8_WAIT_L
#undef PG8_BAR
#undef PG8_SCHED
}
}
#define XB_TMO      128
#define XB_XCNT(j)  (256  + 64 * (j))
#define XB_XSUB(j)  (1280 + 64 * (j))
#define XB_XGEN(j)  (2304 + 64 * (j))
#define XB_TOP      3328
#define XB_TOPGEN   3392
#define XCD_BAR_WORDS 3456
#define XB_SPIN_CAP (1u << 18)
#define LAS __attribute__((address_space(3)))

__device__ __forceinline__ unsigned xb_ld(unsigned* p)              { return __hip_atomic_load(p, __ATOMIC_RELAXED, __HIP_MEMORY_SCOPE_AGENT); }
__device__ __forceinline__ unsigned xb_add(unsigned* p, unsigned v) { return __hip_atomic_fetch_add(p, v, __ATOMIC_RELAXED, __HIP_MEMORY_SCOPE_AGENT); }
__device__ __forceinline__ unsigned xb_xcc_id() { return (unsigned)__builtin_amdgcn_s_getreg((3 << 11) | 20) & 0xFu; }
#define XB_SPIN(cond, bar) do { unsigned _sp = 0; while (cond) { __builtin_amdgcn_s_sleep(1); \
    if ((++_sp & 255u) == 0u) { if (xb_ld(&(bar)[XB_TMO])) break; if (_sp > XB_SPIN_CAP) { atomicAdd(&(bar)[XB_TMO], 1u); break; } } } } while (0)

struct XcdBarrier {
    unsigned* bar; unsigned x;
    volatile LAS unsigned* st;
};

__device__ __forceinline__ XcdBarrier xcd_barrier_post(unsigned* bar, volatile LAS unsigned* st) {
    XcdBarrier b; b.bar = bar; b.x = xb_xcc_id(); b.st = st;
    if (threadIdx.x == 0) (void)xb_add(&bar[XB_XCNT(b.x)], 1u);
    return b;
}
__device__ __forceinline__ void xcd_barrier_complete(unsigned* bar, unsigned x, unsigned& nloc, unsigned& nx) {
    const unsigned G = gridDim.x * gridDim.y * gridDim.z;
    unsigned sum, cnt, mine, sp = 0u;
    for (;;) {
        sum = 0u; cnt = 0u; mine = 0u;
#pragma unroll
        for (unsigned j = 0; j < 16; ++j) { const unsigned c = xb_ld(&bar[XB_XCNT(j)]); sum += c; cnt += (c > 0u) ? 1u : 0u; mine = (j == x) ? c : mine; }
        if (sum == G) break;
        __builtin_amdgcn_s_sleep(1);
        if ((++sp & 255u) == 0u) { if (xb_ld(&bar[XB_TMO])) break; if (sp > XB_SPIN_CAP) { atomicAdd(&bar[XB_TMO], 1u); break; } }
    }
    nloc = mine > 0u ? mine : 1u; nx = cnt > 0u ? cnt : 1u;
}

__device__ __forceinline__ void xcd_barrier(const XcdBarrier& b) {
    asm volatile("s_waitcnt vmcnt(0)" ::: "memory");
    __syncthreads();
    if (threadIdx.x == 0) {
        unsigned* bar = b.bar;
        __builtin_amdgcn_s_waitcnt(0);
        unsigned nloc = b.st[0], nx = b.st[1];
        if (nloc == 0u) { xcd_barrier_complete(bar, b.x, nloc, nx); b.st[0] = nloc; b.st[1] = nx; }
        const unsigned old = xb_add(&bar[XB_XSUB(b.x)], 1u);
        const unsigned gen = old / nloc;
        if (old + 1u == (gen + 1u) * nloc) {
            __builtin_amdgcn_fence(__ATOMIC_RELEASE, "agent");
            asm volatile("s_waitcnt vmcnt(0)" ::: "memory");
            const unsigned og = xb_add(&bar[XB_TOP], 1u);
            const unsigned tg = og / nx;
            if (og + 1u == (tg + 1u) * nx) xb_add(&bar[XB_TOPGEN], 1u);
            else XB_SPIN(xb_ld(&bar[XB_TOPGEN]) == tg, bar);
            __builtin_amdgcn_fence(__ATOMIC_ACQUIRE, "agent");
            xb_add(&bar[XB_XGEN(b.x)], 1u);
            asm volatile("s_waitcnt vmcnt(0)" ::: "memory");
        } else {
            XB_SPIN(xb_ld(&bar[XB_XGEN(b.x)]) == gen, bar);
            __builtin_amdgcn_fence(__ATOMIC_ACQUIRE, "agent");
            asm volatile("s_waitcnt vmcnt(0)" ::: "memory");
        }
    }
    __syncthreads();
}

struct Ctx {
    int tid, lane, wave, G, bid;
    unsigned char* lds;
};

__device__ const double ROPE_INV[16] = {1.0, 0.56234132519034907, 0.31622776601683794, 0.17782794100389229, 0.1, 0.056234132519034911, 0.031622776601683791, 0.017782794100389229,
                                        0.01, 0.005623413251903491, 0.0031622776601683794, 0.0017782794100389228, 0.001, 0.0005623413251903491, 0.00031622776601683794, 0.00017782794100389227};
DI void sincos_d(double x, double& s, double& c) {
    const double kd = rint(x * 0.63661977236758134308);
    const int k = (int)kd;
    double r = fma(-kd, 1.57079632679489655800e+00, x); r = fma(-kd, 6.12323399573676603587e-17, r);
    const double r2 = r * r;
    const double sp = r * (1.0 + r2 * (-1.0 / 6.0 + r2 * (1.0 / 120.0 + r2 * (-1.0 / 5040.0 + r2 * (1.0 / 362880.0 + r2 * (-1.0 / 39916800.0 + r2 * (1.0 / 6227020800.0)))))));
    const double cp = 1.0 + r2 * (-0.5 + r2 * (1.0 / 24.0 + r2 * (-1.0 / 720.0 + r2 * (1.0 / 40320.0 + r2 * (-1.0 / 3628800.0 + r2 * (1.0 / 479001600.0 + r2 * (-1.0 / 87178291200.0)))))));
    const int q = k & 3;
    s = q == 0 ? sp : q == 1 ? cp : q == 2 ? -sp : -cp;
    c = q == 0 ? cp : q == 1 ? -sp : q == 2 ? -cp : sp;
}

DI void phase_mod(const Params& p, const Ctx& c) {
    float* sc = (float*)c.lds;
    float* red = sc + 9 * 1024;
    const float* cond = p.in[I_C]; const float* cctx = p.in[I_CCTX];
    for (int i = c.tid; i < 9 * 1024; i += NTHREADS) { const int cc = i >> 10, k = i & 1023; const float v = cc == 0 ? cctx[k] : cond[(cc - 1) * 1024 + k]; sc[i] = silu_f(v); }
    __syncthreads();
    float* mod = (float*)(p.ws + WS_MOD);
    const float* wmod = p.in[I_WMOD]; const float* bmod = p.in[I_BMOD];
    for (int u = c.bid; u < 192; u += c.G) {
        const int l = u / 96, j0 = (u % 96) * 32, col = c.tid & 31, kg = c.tid >> 5;
        const float* w = wmod + (size_t)l * 1024 * 3072 + j0 + col;
        float acc[9];
#pragma unroll
        for (int cc = 0; cc < 9; ++cc) acc[cc] = 0.f;
#pragma unroll 8
        for (int kk = 0; kk < 64; ++kk) { const int k = kg * 64 + kk; const float wv = w[(size_t)k * 3072];
#pragma unroll
            for (int cc = 0; cc < 9; ++cc) acc[cc] += sc[cc * 1024 + k] * wv; }
#pragma unroll
        for (int cc = 0; cc < 9; ++cc) red[(kg * 9 + cc) * 32 + col] = acc[cc];
        __syncthreads();
        if (c.tid < 288) { const int cc = c.tid >> 5, c2 = c.tid & 31; float s = 0.f;
#pragma unroll
            for (int g = 0; g < 16; ++g) s += red[(g * 9 + cc) * 32 + c2];
            mod[(size_t)(l * 9 + cc) * 3072 + j0 + c2] = s + bmod[l * 3072 + j0 + c2]; }
        __syncthreads();
    }
    if (c.bid == c.G - 1) {
        float* rt = (float*)(p.ws + WS_ROPE);
        for (int i = c.tid; i < 1024; i += NTHREADS) { const int pos = i >> 4, k = i & 15; double s, co; sincos_d((double)pos * ROPE_INV[k], s, co); rt[2 * i] = (float)co; rt[2 * i + 1] = (float)s; }
        if (c.tid < 2) { const float* dl = p.in[I_DLAM] + c.tid * 256; float s01 = 0.f, s23 = 0.f;
            for (int i = 0; i < 64; ++i) { s01 += dl[i] * dl[64 + i]; s23 += dl[128 + i] * dl[192 + i]; }
            const float lam_i = c.tid == 0 ? 0.2f : 0.35550906759096934f;
            ((float*)(p.ws + WS_MISC))[c.tid] = expf(s01) - expf(s23) + lam_i; }
    }
}

DI void rows_pass(const Params& p, const Ctx& c, int post_l, int pre_l) {
    const float* mod = (const float*)(p.ws + WS_MOD);
    const float* Y = (const float*)(p.ws + WS_R1);
    bf16* H = (bf16*)(p.ws + WS_HM);
    const int gw = c.bid * 8 + c.wave, NGW = c.G * 8;
    for (int m = gw; m < NTOK; m += NGW) {
        const int cidx = m < NCTX ? 0 : 1 + ((m - NCTX) >> 10);
        const float* xrow = post_l == 1 ? p.out + (size_t)m * 1024 : (m < NCTX ? p.in[I_XP] + (size_t)m * 1024 : p.in[I_XS] + (size_t)(m - NCTX) * 1024);
        f32x4 v[4];
#pragma unroll
        for (int j = 0; j < 4; ++j) v[j] = *(const f32x4*)(xrow + 256 * j + 4 * c.lane);
        if (post_l >= 0) {
            f32x4 y[4]; float ss = 0.f;
#pragma unroll
            for (int j = 0; j < 4; ++j) { y[j] = *(const f32x4*)(Y + (size_t)m * 1024 + 256 * j + 4 * c.lane); ss += (y[j][0] * y[j][0] + y[j][1] * y[j][1]) + (y[j][2] * y[j][2] + y[j][3] * y[j][3]); }
#pragma unroll
            for (int o = 1; o < 64; o <<= 1) ss += __shfl_xor(ss, o);
            const float rs = 1.0f / sqrtf(ss * (1.0f / 1024.0f) + EPS);
            const float* gate = mod + (size_t)(post_l * 9 + cidx) * 3072 + 2048; const float* gp = p.in[I_GPOST] + post_l * 1024;
#pragma unroll
            for (int j = 0; j < 4; ++j) { const f32x4 g4 = *(const f32x4*)(gate + 256 * j + 4 * c.lane), p4 = *(const f32x4*)(gp + 256 * j + 4 * c.lane);
                v[j] = v[j] + g4 * (y[j] * rs * p4);
                *(f32x4*)(p.out + (size_t)m * 1024 + 256 * j + 4 * c.lane) = v[j]; }
        }
        if (pre_l >= 0) {
            float ss = 0.f;
#pragma unroll
            for (int j = 0; j < 4; ++j) ss += (v[j][0] * v[j][0] + v[j][1] * v[j][1]) + (v[j][2] * v[j][2] + v[j][3] * v[j][3]);
#pragma unroll
            for (int o = 1; o < 64; o <<= 1) ss += __shfl_xor(ss, o);
            const float rs = 1.0f / sqrtf(ss * (1.0f / 1024.0f) + EPS);
            const float* sh = mod + (size_t)(pre_l * 9 + cidx) * 3072; const float* scl = sh + 1024; const float* gpre = p.in[I_GPRE] + pre_l * 1024;
#pragma unroll
            for (int j = 0; j < 4; ++j) { const f32x4 s4 = *(const f32x4*)(sh + 256 * j + 4 * c.lane), c4 = *(const f32x4*)(scl + 256 * j + 4 * c.lane), g4 = *(const f32x4*)(gpre + 256 * j + 4 * c.lane);
                const f32x4 h = (v[j] * rs * g4) * (c4 + 1.0f) + s4;
                u32x2 w; w.x = pk2(h[0], h[1]); w.y = pk2(h[2], h[3]);
                *(u32x2*)(H + (size_t)m * 1024 + 256 * j + 4 * c.lane) = w; }
        }
    }
}

DI void transpose_item(const float* W, int N, bf16* WT, int K, int k0, int n0, int R0, float* scr, int lane) {
#pragma unroll 8
    for (int i = 0; i < 32; ++i) { const int kk = 2 * i + (lane >> 5); scr[kk * 33 + (lane & 31)] = W[(size_t)(k0 + kk) * N + n0 + (lane & 31)]; }
    LDS_WAIT();
    const int cc = lane & 7;
#pragma unroll
    for (int j = 0; j < 4; ++j) { const int n = (lane >> 3) + 8 * j; const float* s = scr + (8 * cc) * 33 + n;
        u32x4 o; o.x = pk2(s[0 * 33], s[1 * 33]); o.y = pk2(s[2 * 33], s[3 * 33]); o.z = pk2(s[4 * 33], s[5 * 33]); o.w = pk2(s[6 * 33], s[7 * 33]);
        *(u32x4*)(WT + (size_t)(R0 + n) * K + k0 + 8 * cc) = o; }
    LDS_WAIT();
}
DI void convert_weights(const Params& p, const Ctx& c) {
    float* scr = (float*)(c.lds + c.wave * 16384);
    const int gw = c.bid * 8 + c.wave, NGW = c.G * 8;
    constexpr int I_IN = 16 * 104, I_OUT = 16 * 32, NITEMS = 2 * (I_IN + I_OUT);
    for (int it = gw; it < NITEMS; it += NGW) {
        int r = it; const int l = r / (I_IN + I_OUT); r -= l * (I_IN + I_OUT);
        if (r < I_IN) { const int kb = r / 104, nb = r % 104, n0 = 32 * nb, pn = n0 >> 8, within = n0 & 255, wc = within >> 6, bj = (within >> 5) & 1;
            transpose_item(p.in[I_WIN] + (size_t)l * 1024 * NIN, NIN, (bf16*)(p.ws + WS_WIN) + (size_t)l * NIN * 1024, 1024, 64 * kb, n0, 256 * pn + 128 * bj + 32 * wc, scr, c.lane);
        } else { r -= I_IN; const int kb = r / 32, nb = r % 32;
            transpose_item(p.in[I_WOUT] + (size_t)l * 1024 * 1024, 1024, (bf16*)(p.ws + WS_WOUT) + (size_t)l * 1024 * 1024, 1024, 64 * kb, 32 * nb, 32 * nb, scr, c.lane); }
    }
    bf16* wg = (bf16*)(p.ws + WS_WG);
    for (int i = c.bid * NTHREADS + c.tid; i < 2 * 2 * 2 * 4 * 4096; i += c.G * NTHREADS) {
        const int cc = i & 63, d = (i >> 6) & 63, n = (i >> 12) & 3, gate = (i >> 14) & 1, dir = (i >> 15) & 1, l = i >> 16;
        const float v = (gate ? p.in[I_WX] : p.in[I_WA])[(size_t)(((l * 2 + dir) * 4 + n) * 64 + cc) * 64 + d];
        wg[i] = (bf16)(pk2(v, 0.f) & 0xffffu);
    }
}
DI void convert_caches(const Params& p, const Ctx& c, int l) {
    const int gt = c.bid * NTHREADS + c.tid, NGT = c.G * NTHREADS;
    {
        const float* src = p.in[I_CGK]; bf16* dst = (bf16*)(p.ws + WS_KGL);
        for (int i = gt; i < 8 * 2 * 512 * 16; i += NGT) { const int d4 = i & 15, key = (i >> 4) & 511, kvh = (i >> 13) & 1, b = i >> 14;
            const f32x4 v = *(const f32x4*)(src + ((size_t)(b * 2 + l) * 512 + key) * 128 + kvh * 64 + 4 * d4);
            u32x2 w; w.x = pk2(v[0], v[1]); w.y = pk2(v[2], v[3]); *(u32x2*)(dst + ((size_t)(b * 2 + kvh) * 1536 + key) * 64 + 4 * d4) = w; }
    }
    {
        const float* src = p.in[I_CDK]; bf16* dst = (bf16*)(p.ws + WS_KDL);
        for (int i = gt; i < 8 * 8 * 512 * 16; i += NGT) { const int d4 = i & 15, key = (i >> 4) & 511, idx = (i >> 13) & 7, b = i >> 16;
            const f32x4 v = *(const f32x4*)(src + ((size_t)(b * 2 + l) * 512 + key) * 512 + idx * 64 + 4 * d4);
            u32x2 w; w.x = pk2(v[0], v[1]); w.y = pk2(v[2], v[3]); *(u32x2*)(dst + ((size_t)(b * 8 + idx) * 1536 + key) * 64 + 4 * d4) = w; }
    }
    {
        const float* src = p.in[I_CGV]; bf16* dst = (bf16*)(p.ws + WS_VGL);
        for (int i = gt; i < 8 * 2 * 128 * 64; i += NGT) { const int dv = i & 63, k4 = (i >> 6) & 127, kvh = (i >> 13) & 1, b = i >> 14;
            const float* s = src + ((size_t)(b * 2 + l) * 512 + 4 * k4) * 128 + kvh * 64 + dv;
            u32x2 w; w.x = pk2(s[0], s[128]); w.y = pk2(s[256], s[384]); *(u32x2*)(dst + ((size_t)(b * 2 + kvh) * 64 + dv) * 1536 + 4 * k4) = w; }
    }
    {
        const float* src = p.in[I_CDV]; bf16* dst = (bf16*)(p.ws + WS_VDL);
        for (int i = gt; i < 8 * 4 * 128 * 128; i += NGT) { const int dv = i & 127, k4 = (i >> 7) & 127, h = (i >> 14) & 3, b = i >> 16;
            const float* s = src + ((size_t)(b * 2 + l) * 512 + 4 * k4) * 512 + h * 128 + dv;
            u32x2 w; w.x = pk2(s[0], s[512]); w.y = pk2(s[1024], s[1536]); *(u32x2*)(dst + ((size_t)(b * 4 + h) * 128 + dv) * 1536 + 4 * k4) = w; }
    }
}

template <bool REV>
DI void tile_scan(float (&a)[16], float (&x)[16], int h, float& Pt, float& Yt) {
    float A[4], B[4];
#pragma unroll
    for (int g = 0; g < 4; ++g) {
        float y, pp;
        if (!REV) { y = x[4 * g]; pp = a[4 * g];
#pragma unroll
            for (int i = 1; i < 4; ++i) { const float ai = a[4 * g + i]; y = ai * y + x[4 * g + i]; pp = ai * pp; x[4 * g + i] = y; a[4 * g + i] = pp; } }
        else { y = x[4 * g + 3]; pp = a[4 * g + 3];
#pragma unroll
            for (int i = 2; i >= 0; --i) { const float ai = a[4 * g + i]; y = ai * y + x[4 * g + i]; pp = ai * pp; x[4 * g + i] = y; a[4 * g + i] = pp; } }
        A[g] = pp; B[g] = y;
    }
    float pA[4], pB[4];
#pragma unroll
    for (int g = 0; g < 4; ++g) { pA[g] = __shfl_xor(A[g], 32); pB[g] = __shfl_xor(B[g], 32); }
    float cin = 0.f, Pin = 1.f, cown[4] = {0.f, 0.f, 0.f, 0.f}, pown[4] = {1.f, 1.f, 1.f, 1.f};
#pragma unroll
    for (int s = 0; s < 8; ++s) { const int sc = REV ? 7 - s : s, g = sc >> 1, hh = sc & 1;
        const bool mine = (hh == h);
        const float As = mine ? A[g] : pA[g], Bs = mine ? B[g] : pB[g];
        cown[g] = mine ? cin : cown[g]; pown[g] = mine ? Pin : pown[g];
        cin = Bs + As * cin; Pin = As * Pin; }
#pragma unroll
    for (int g = 0; g < 4; ++g)
#pragma unroll
        for (int i = 0; i < 4; ++i) { x[4 * g + i] = x[4 * g + i] + a[4 * g + i] * cown[g]; a[4 * g + i] = a[4 * g + i] * pown[g]; }
    Pt = Pin; Yt = cin;
}

DI void phase_lru_gates(const Params& p, const Ctx& c, int l) {
    float* U = (float*)(c.lds + c.wave * 8704);
    const int n = c.wave & 3, dir = c.wave >> 2, r = c.lane & 31, h = c.lane >> 5;
    const bf16* wg = (const bf16*)(p.ws + WS_WG) + (size_t)(((l * 2 + dir) * 2) * 4 + n) * 4096;
    bf16x8 Bf[2][2][4];
#pragma unroll
    for (int g2 = 0; g2 < 2; ++g2)
#pragma unroll
        for (int dt = 0; dt < 2; ++dt)
#pragma unroll
            for (int ks = 0; ks < 4; ++ks) Bf[g2][dt][ks] = *(const bf16x8*)(wg + (size_t)g2 * 4 * 4096 + (32 * dt + r) * 64 + 16 * ks + 8 * h);
    float ba[2], bx[2], cd[2];
#pragma unroll
    for (int dt = 0; dt < 2; ++dt) { const int ch = (l * 2 + dir) * 256 + 64 * n + 32 * dt + r;
        ba[dt] = p.in[I_BA][ch]; bx[dt] = p.in[I_BX][ch]; cd[dt] = -8.0f * log1pf(expf(-p.in[I_LAM][ch])); }
    const int chl = 64 * n + c.lane;
    const float w0 = p.in[I_CONVW][(l * 4 + 0) * 256 + chl], w1 = p.in[I_CONVW][(l * 4 + 1) * 256 + chl], w2 = p.in[I_CONVW][(l * 4 + 2) * 256 + chl], w3 = p.in[I_CONVW][(l * 4 + 3) * 256 + chl];
    const float cb = p.in[I_CONVB][l * 256 + chl];
    const float* LX = (const float*)(p.ws + WS_LX);
    float* Yl = (float*)(p.ws + WS_R1) + (size_t)dir * NTOK * 256;
    float* Pp = (float*)(p.ws + WS_R1) + (size_t)(2 + dir) * NTOK * 256;
    float* Sm = (float*)(p.ws + WS_YF);
    for (int tile = c.bid; tile < 512; tile += c.G) {
        const int tok0 = tile * 32;
        int seq0, T;
        if (tok0 < NCTX) { seq0 = tok0 & ~255; T = 256; } else { seq0 = NCTX + ((tok0 - NCTX) & ~1023); T = 1024; }
        const int t0 = tok0 - seq0;
        float xw[35];
#pragma unroll
        for (int i = 0; i < 35; ++i) { const int t = t0 - 2 + i; xw[i] = (t >= 0 && t < T) ? LX[(size_t)(seq0 + t) * 256 + chl] : 0.f; }
#pragma unroll
        for (int tt = 0; tt < 32; ++tt) U[tt * 68 + c.lane] = cb + w0 * xw[tt] + w1 * xw[tt + 1] + w2 * xw[tt + 2] + w3 * xw[tt + 3];
        LDS_WAIT();
        bf16x8 Af[4];
#pragma unroll
        for (int ks = 0; ks < 4; ++ks) { const f32x4 a0 = *(const f32x4*)(U + r * 68 + 16 * ks + 8 * h), a1 = *(const f32x4*)(U + r * 68 + 16 * ks + 8 * h + 4);
            u32x4 w; w.x = pk2(a0[0], a0[1]); w.y = pk2(a0[2], a0[3]); w.z = pk2(a1[0], a1[1]); w.w = pk2(a1[2], a1[3]); Af[ks] = __builtin_bit_cast(bf16x8, w); }
        f32x16 acc[2][2];
#pragma unroll
        for (int g2 = 0; g2 < 2; ++g2)
#pragma unroll
            for (int dt = 0; dt < 2; ++dt) {
#pragma unroll
                for (int i = 0; i < 16; ++i) acc[g2][dt][i] = 0.f;
#pragma unroll
                for (int ks = 0; ks < 4; ++ks) acc[g2][dt] = MFMA32(Af[ks], Bf[g2][dt][ks], acc[g2][dt]);
            }
#pragma unroll
        for (int dt = 0; dt < 2; ++dt) {
            float av[16], xv[16];
#pragma unroll
            for (int i = 0; i < 16; ++i) {
                const int tt = (i & 3) + 8 * (i >> 2) + 4 * h, d = 32 * dt + r;
                const float uu = U[tt * 68 + d];
                const float rr = __builtin_amdgcn_rcpf(1.0f + __expf(-(acc[0][dt][i] + ba[dt]))), ii = __builtin_amdgcn_rcpf(1.0f + __expf(-(acc[1][dt][i] + bx[dt])));
                const float a = __expf(rr * cd[dt]);
                av[i] = a; xv[i] = sqrtf(fmaf(-a, a, 1.0f)) * ii * uu;
            }
            float Pt, Yt;
            if (dir == 0) tile_scan<false>(av, xv, h, Pt, Yt); else tile_scan<true>(av, xv, h, Pt, Yt);
#pragma unroll
            for (int i = 0; i < 16; ++i) { const int tt = (i & 3) + 8 * (i >> 2) + 4 * h;
                const size_t o = (size_t)(tok0 + tt) * 256 + 64 * n + 32 * dt + r;
                Yl[o] = xv[i]; Pp[o] = av[i]; }
            if (h == 0) { f32x2 sm; sm.x = Pt; sm.y = Yt; *(f32x2*)(Sm + ((size_t)(dir * 512 + tile) * 256 + 64 * n + 32 * dt + r) * 2) = sm; }
        }
        LDS_WAIT();
    }
}

DI void scan_unit(const Params& p, const Ctx& c_, int l, int u) {
    Ctx c = c_; asm volatile("" : "+v"(c.tid)); c.lane = c.tid & 63;
    const bool lat = u >= 64; const int b = lat ? ((u - 64) >> 3) : (u >> 1), NT = lat ? 32 : 8, tile0 = lat ? 256 + b * 32 : b * 8, lt0 = 4 * u - tile0;
    float* HIN = (float*)c.lds;
    {
        const int dir = c.tid >> 8, ch = c.tid & 255;
        const float* Sm = (const float*)(p.ws + WS_YF) + ((size_t)(dir * 512 + tile0) * 256 + ch) * 2;
        float hst = lat ? p.in[I_SLRU][((b * 2 + l) * 2 + dir) * 256 + ch] : 0.f;
        for (int k0 = 0; k0 < NT; k0 += 8) {
            f32x2 sm[8];
#pragma unroll
            for (int i = 0; i < 8; ++i) { const int k = dir ? NT - 1 - (k0 + i) : k0 + i; sm[i] = *(const f32x2*)(Sm + (size_t)k * 512); }
#pragma unroll
            for (int i = 0; i < 8; ++i) { const int k = dir ? NT - 1 - (k0 + i) : k0 + i;
                if (k >= lt0 && k < lt0 + 4) HIN[(dir * 4 + (k - lt0)) * 256 + ch] = hst;
                hst = sm[i].y + sm[i].x * hst; }
        }
        if (!lat && (u & 1) == 0) p.out[OUT_LRU + (size_t)((b * 2 + l) * 2 + dir) * 256 + ch] = hst;
    }
    __syncthreads();
    const float* R1 = (const float*)(p.ws + WS_R1);
    const bf16* GS = (const bf16*)(p.ws + WS_GS); bf16* MIX = (bf16*)(p.ws + WS_HM);
#pragma unroll 4
    for (int it = 0; it < 16; ++it) { const int idx = it * NTHREADS + c.tid, tokl = idx >> 6, c4 = (idx & 63) * 4, tl = tokl >> 5; const size_t o = (size_t)(128 * u + tokl) * 256 + c4;
        const f32x4 ylf = *(const f32x4*)(R1 + o), ylb = *(const f32x4*)(R1 + (size_t)NTOK * 256 + o), ppf = *(const f32x4*)(R1 + (size_t)2 * NTOK * 256 + o), ppb = *(const f32x4*)(R1 + (size_t)3 * NTOK * 256 + o);
        const f32x4 hf = *(const f32x4*)(HIN + tl * 256 + c4), hb = *(const f32x4*)(HIN + (4 + tl) * 256 + c4);
        const u32x2 g = *(const u32x2*)(GS + (size_t)(128 * u + tokl) * 1024 + c4);
        const f32x4 y = (ylf + ppf * hf) + (ylb + ppb * hb);
        u32x2 w; w.x = pk2(y[0] * bflo(g.x), y[1] * bfhi(g.x)); w.y = pk2(y[2] * bflo(g.y), y[3] * bfhi(g.y));
        *(u32x2*)(MIX + (size_t)(128 * u + tokl) * 1024 + c4) = w; }
    __syncthreads();
}

constexpr int AT_KB = 9216, AT_VOFF = 18432, AT_BUF = 36864;
template <int DV>
DI void attn_unit(const Params& p, const Ctx& c_, int l, bool lat, int b, int hd, int qb) {
    Ctx c = c_; asm volatile("" : "+v"(c.tid)); c.lane = c.tid & 63;
    constexpr int NK = DV == 128 ? 2 : 1, NV = DV / 64, NDT = DV / 32;
    const int Tk = lat ? LAT_TK : CTX_T;
    const int tokb = lat ? NCTX + b * LAT_T + qb * 128 : b * CTX_T + qb * 128;
    const int side = c.wave >> 2, wq = c.wave & 3, r = c.lane & 31, h = c.lane >> 5;
    const int tok = tokb + 32 * wq + r;
    const bf16* Qp = DV == 64 ? (const bf16*)(p.ws + WS_QG) + (size_t)tok * 256 + 64 * (2 * hd + side) : (const bf16*)(p.ws + WS_QD) + (size_t)tok * 512 + 64 * (2 * hd + side);
    const bf16* Kb[NK];
    const bf16* Vb;
    if (DV == 64) { Kb[0] = lat ? (const bf16*)(p.ws + WS_KGL) + (size_t)(b * 2 + hd) * 1536 * 64 : (const bf16*)(p.ws + WS_KGC) + (size_t)(b * 2 + hd) * 256 * 64;
        Vb = lat ? (const bf16*)(p.ws + WS_VGL) + (size_t)(b * 2 + hd) * 64 * 1536 : (const bf16*)(p.ws + WS_VGC) + (size_t)(b * 2 + hd) * 64 * 256; }
    else {
#pragma unroll
        for (int s = 0; s < NK; ++s) Kb[s] = lat ? (const bf16*)(p.ws + WS_KDL) + (size_t)(b * 8 + 2 * hd + s) * 1536 * 64 : (const bf16*)(p.ws + WS_KDC) + (size_t)(b * 8 + 2 * hd + s) * 256 * 64;
        Vb = lat ? (const bf16*)(p.ws + WS_VDL) + (size_t)(b * 4 + hd) * 128 * 1536 : (const bf16*)(p.ws + WS_VDC) + (size_t)(b * 4 + hd) * 128 * 256; }
    bf16x8 qf[4];
#pragma unroll
    for (int ks = 0; ks < 4; ++ks) qf[ks] = *(const bf16x8*)(Qp + 16 * ks + 8 * h);
    const int srow = c.tid >> 3, sch = c.tid & 7;
    u32x4 kreg[NK], vreg[NV];
    unsigned char* lds = c.lds;
#define STAGE_LOAD(k0_) do { const int k0__ = (k0_); \
        _Pragma("unroll") for (int s_ = 0; s_ < NK; ++s_) kreg[s_] = *(const u32x4*)(Kb[s_] + (size_t)(k0__ + srow) * 64 + 8 * sch); \
        _Pragma("unroll") for (int v_ = 0; v_ < NV; ++v_) vreg[v_] = *(const u32x4*)(Vb + (size_t)(srow + 64 * v_) * Tk + k0__ + 8 * sch); } while (0)
#define STAGE_WRITE(buf_) do { unsigned char* B_ = lds + (buf_) * AT_BUF; \
        _Pragma("unroll") for (int s_ = 0; s_ < NK; ++s_) *(u32x4*)(B_ + s_ * AT_KB + srow * 144 + sch * 16) = kreg[s_]; \
        _Pragma("unroll") for (int v_ = 0; v_ < NV; ++v_) { unsigned char* d_ = B_ + AT_VOFF + (srow + 64 * v_) * 144 + (sch >> 1) * 32 + (sch & 1) * 8; \
            u32x2 lo_, hi_; lo_.x = vreg[v_].x; lo_.y = vreg[v_].y; hi_.x = vreg[v_].z; hi_.y = vreg[v_].w; *(u32x2*)d_ = lo_; *(u32x2*)(d_ + 16) = hi_; } } while (0)
    f32x16 o[NDT];
#pragma unroll
    for (int dt = 0; dt < NDT; ++dt)
#pragma unroll
        for (int i = 0; i < 16; ++i) o[dt][i] = 0.f;
    float mrun = 0.f, lrun = 0.f;
    const int nt = Tk / 64;
    STAGE_LOAD(0); STAGE_WRITE(0);
    __syncthreads();
    for (int j = 0; j < nt; ++j) {
        if (j + 1 < nt) STAGE_LOAD((j + 1) * 64);
        const unsigned char* B = lds + (j & 1) * AT_BUF;
        const unsigned char* Kt = B + (DV == 128 ? side * AT_KB : 0);
        const unsigned char* Vt = B + AT_VOFF;
        f32x16 s[2];
        const float sinit = j == 0 ? 0.f : -mrun;
#pragma unroll
        for (int kb = 0; kb < 2; ++kb) {
#pragma unroll
            for (int i = 0; i < 16; ++i) s[kb][i] = sinit;
#pragma unroll
            for (int ks = 0; ks < 4; ++ks) { const bf16x8 kf = *(const bf16x8*)(Kt + (32 * kb + r) * 144 + (16 * ks + 8 * h) * 2); s[kb] = MFMA32(kf, qf[ks], s[kb]); }
        }
        float mx = fmaxf(s[0][0], s[1][0]);
#pragma unroll
        for (int i = 1; i < 16; ++i) mx = fmaxf(fmaxf(mx, s[0][i]), s[1][i]);
        mx = fmaxf(mx, __shfl_xor(mx, 32));
        if (j == 0 || !__all(mx <= 8.0f)) {
            const float d = j == 0 ? mx : fmaxf(mx, 0.f), alpha = __builtin_amdgcn_exp2f(-d);
            mrun = j == 0 ? d : mrun + d;
            lrun *= alpha;
#pragma unroll
            for (int kb = 0; kb < 2; ++kb)
#pragma unroll
                for (int i = 0; i < 16; ++i) s[kb][i] -= d;
#pragma unroll
            for (int dt = 0; dt < NDT; ++dt)
#pragma unroll
                for (int i = 0; i < 16; ++i) o[dt][i] *= alpha;
        }
        float ls = 0.f;
#pragma unroll
        for (int kb = 0; kb < 2; ++kb)
#pragma unroll
            for (int i = 0; i < 16; ++i) { const float e = __builtin_amdgcn_exp2f(s[kb][i]); s[kb][i] = e; ls += e; }
        lrun += ls;
#pragma unroll
        for (int kb = 0; kb < 2; ++kb)
#pragma unroll
            for (int s2 = 0; s2 < 2; ++s2) {
                u32x4 pw; pw.x = pk2(s[kb][8 * s2 + 0], s[kb][8 * s2 + 1]); pw.y = pk2(s[kb][8 * s2 + 2], s[kb][8 * s2 + 3]); pw.z = pk2(s[kb][8 * s2 + 4], s[kb][8 * s2 + 5]); pw.w = pk2(s[kb][8 * s2 + 6], s[kb][8 * s2 + 7]);
                const bf16x8 pf = __builtin_bit_cast(bf16x8, pw);
#pragma unroll
                for (int dt = 0; dt < NDT; ++dt) { const bf16x8 vf = *(const bf16x8*)(Vt + (32 * dt + r) * 144 + (32 * kb + 16 * s2) * 2 + 16 * h);
                    o[dt] = MFMA32(vf, pf, o[dt]); }
            }
        if (j + 1 < nt) STAGE_WRITE((j + 1) & 1);
        __syncthreads();
    }
    const float ltot = lrun + __shfl_xor(lrun, 32), inv = 1.0f / ltot;
#pragma unroll
    for (int dt = 0; dt < NDT; ++dt)
#pragma unroll
        for (int i = 0; i < 16; ++i) o[dt][i] *= inv;
    const bf16* GS = (const bf16*)(p.ws + WS_GS); bf16* MIX = (bf16*)(p.ws + WS_HM);
    if (DV == 64) {
        const int colb = 256 + 64 * (2 * hd + side);
#pragma unroll
        for (int dt = 0; dt < NDT; ++dt)
#pragma unroll
            for (int g4 = 0; g4 < 4; ++g4) { const int col = colb + 32 * dt + 8 * g4 + 4 * h;
                const u32x2 g = *(const u32x2*)(GS + (size_t)tok * 1024 + col);
                u32x2 w; w.x = pk2(o[dt][4 * g4] * bflo(g.x), o[dt][4 * g4 + 1] * bfhi(g.x)); w.y = pk2(o[dt][4 * g4 + 2] * bflo(g.y), o[dt][4 * g4 + 3] * bfhi(g.y));
                *(u32x2*)(MIX + (size_t)tok * 1024 + col) = w; }
    } else {
        float* Xc = (float*)lds;
        if (side == 1) {
#pragma unroll
            for (int dt = 0; dt < NDT; ++dt)
#pragma unroll
                for (int i = 0; i < 16; ++i) Xc[((wq * NDT + dt) * 16 + i) * 64 + c.lane] = o[dt][i];
        }
        __syncthreads();
        if (side == 0) {
            const float lam = ((const float*)(p.ws + WS_MISC))[l];
            const float oml = l == 0 ? 0.8f : (1.0f - 0.35550906759096934f);
            float ss = 0.f;
#pragma unroll
            for (int dt = 0; dt < NDT; ++dt)
#pragma unroll
                for (int i = 0; i < 16; ++i) { const float v = o[dt][i] - lam * Xc[((wq * NDT + dt) * 16 + i) * 64 + c.lane]; o[dt][i] = v; ss += v * v; }
            ss += __shfl_xor(ss, 32);
            const float rs = oml / sqrtf(ss * (1.0f / 128.0f) + EPS);
            const float* gsub = p.in[I_GSUB] + l * 128;
#pragma unroll
            for (int dt = 0; dt < NDT; ++dt)
#pragma unroll
                for (int g4 = 0; g4 < 4; ++g4) { const int dv = 32 * dt + 8 * g4 + 4 * h, col = 512 + 128 * hd + dv;
                    const u32x2 g = *(const u32x2*)(GS + (size_t)tok * 1024 + col); const f32x4 gb = *(const f32x4*)(gsub + dv);
                    u32x2 w; w.x = pk2(o[dt][4 * g4] * rs * gb[0] * bflo(g.x), o[dt][4 * g4 + 1] * rs * gb[1] * bfhi(g.x)); w.y = pk2(o[dt][4 * g4 + 2] * rs * gb[2] * bflo(g.y), o[dt][4 * g4 + 3] * rs * gb[3] * bfhi(g.y));
                    *(u32x2*)(MIX + (size_t)tok * 1024 + col) = w; }
        }
        __syncthreads();
    }
}

#undef STAGE_LOAD
#undef STAGE_WRITE
constexpr int Q_SCAN = 128, Q_LD = Q_SCAN + 256, Q_LG = Q_LD + 128, Q_CD = Q_LG + 256, Q_CG = Q_CD + 128;
DI void phase_queue(const Params& p, const Ctx& c, int l, int hsel) {
    unsigned* head = (unsigned*)(p.ws + WS_CTL) + CW_QUEUE + 64 * (l + hsel);
    volatile LAS unsigned* bc = (volatile LAS unsigned*)((LAS unsigned char*)c.lds + LDS_CTRL + 64);
    for (;;) {
        if (c.tid == 0) *bc = __hip_atomic_fetch_add(head, 1u, __ATOMIC_RELAXED, __HIP_MEMORY_SCOPE_AGENT);
        __syncthreads();
        const int u = (int)*bc;
        __syncthreads();
        if (u >= Q_CG) break;
        if (u < Q_SCAN) { if (hsel == 0) scan_unit(p, c, l, u); }
        else if (u < Q_LD) { const int i = u - Q_SCAN; attn_unit<128>(p, c, l, true, i >> 5, (i >> 3) & 3, i & 7); }
        else if (u < Q_LG) { const int i = u - Q_LD; attn_unit<64>(p, c, l, true, i >> 4, (i >> 3) & 1, i & 7); }
        else if (u < Q_CD) { const int i = u - Q_LG; attn_unit<128>(p, c, l, false, i >> 3, (i >> 1) & 3, i & 1); }
        else { const int i = u - Q_CD; attn_unit<64>(p, c, l, false, i >> 2, (i >> 1) & 1, i & 1); }
    }
}

constexpr int N_PHASES = 12;
#ifndef MK_SPLIT
#define MK_SPLIT 0
#endif
__global__ void __launch_bounds__(NTHREADS, 2) hybrid_fwd(Params p) {
    __shared__ __attribute__((aligned(16))) unsigned char smem[LDS_BYTES];
    Ctx c; c.tid = threadIdx.x; c.lane = c.tid & 63; c.wave = __builtin_amdgcn_readfirstlane(c.tid >> 6); c.G = gridDim.x; c.bid = blockIdx.x; c.lds = smem;
    LAS unsigned char* lds3 = (LAS unsigned char*)smem;
    if (c.tid < 64) ((LAS unsigned*)(lds3 + LDS_CTRL))[c.tid] = 0u;
    __syncthreads();
    unsigned* ctl = (unsigned*)(p.ws + WS_CTL);
    XcdBarrier bar; bar.bar = ctl + CW_BAR; bar.x = 0; bar.st = nullptr;
    if (p.ph_hi - p.ph_lo > 1) bar = xcd_barrier_post(ctl + CW_BAR, (volatile LAS unsigned*)(lds3 + LDS_CTRL));
#define IN(k) (p.ph_lo <= (k) && (k) < p.ph_hi)
#define SEAM(k) do { if (IN(k) && IN((k) + 1)) xcd_barrier(bar); } while (0)
#if defined(DUP_P0)
    phase_mod(p, c); xcd_barrier(bar);
#endif
    if (IN(0)) phase_mod(p, c);
    SEAM(0);
#if defined(DUP_P1)
    rows_pass(p, c, -1, 0); convert_weights(p, c); convert_caches(p, c, 0); xcd_barrier(bar);
#endif
#if defined(DUP_P1A)
    rows_pass(p, c, -1, 0); xcd_barrier(bar);
#endif
#if defined(DUP_P1B)
    convert_weights(p, c); xcd_barrier(bar);
#endif
    if (IN(1)) { rows_pass(p, c, -1, 0); convert_weights(p, c); convert_caches(p, c, 0); }
    SEAM(1);
#define RUN_INPROJ(l) { \
        pg8::Gemm g{(const pg8::bf16_t*)(p.ws + WS_HM), (const pg8::bf16_t*)(p.ws + WS_WIN) + (size_t)(l) * NIN * 1024, NTOK, NIN, 1024}; \
        pg8::StaticOrder S; S.init(NTOK, NIN, c.G, c.bid); \
        pg8::EpiIn E{l, p.out, p.ws, p.in[I_GQ] + (l) * 64, p.in[I_GK] + (l) * 64}; \
        pg8::gemm_phase<pg8::EpiIn, pg8::StaticOrder, true, true>(lds3, g, S, E); }
#define RUN_OUTPROJ(l) { \
        pg8::Gemm g{(const pg8::bf16_t*)(p.ws + WS_HM), (const pg8::bf16_t*)(p.ws + WS_WOUT) + (size_t)(l) * 1024 * 1024, NTOK, 1024, 1024}; \
        pg8::StaticOrder S; S.init(NTOK, 1024, c.G, c.bid); \
        pg8::EpiY E{(float*)(p.ws + WS_R1)}; \
        pg8::gemm_phase<pg8::EpiY, pg8::StaticOrder, true, true>(lds3, g, S, E); }
#if defined(DUP_INPROJ)
#define DUPI(l) RUN_INPROJ(l) xcd_barrier(bar);
#else
#define DUPI(l)
#endif
#if defined(DUP_GATES)
#define DUPG(l) phase_lru_gates(p, c, l); xcd_barrier(bar);
#else
#define DUPG(l)
#endif
#if defined(DUP_QUEUE)
#define DUPQ(l) phase_queue(p, c, l, 2); xcd_barrier(bar);
#else
#define DUPQ(l)
#endif
#if defined(DUP_OUTPROJ)
#define DUPO(l) RUN_OUTPROJ(l) xcd_barrier(bar);
#else
#define DUPO(l)
#endif
#if defined(DUP_ROWS)
#define DUPR(l) if ((l) == 0) { rows_pass(p, c, 0, 1); xcd_barrier(bar); }
#else
#define DUPR(l)
#endif
#define LAYER(l, base) \
    DUPI(l) \
    if (IN(base)) RUN_INPROJ(l) \
    SEAM(base); \
    DUPG(l) \
    if (IN(base + 1)) phase_lru_gates(p, c, l); \
    SEAM(base + 1); \
    DUPQ(l) \
    if (IN(base + 2)) phase_queue(p, c, l, 0); \
    SEAM(base + 2); \
    DUPO(l) \
    if (IN(base + 3)) RUN_OUTPROJ(l) \
    SEAM(base + 3); \
    DUPR(l) \
    if (IN(base + 4)) { rows_pass(p, c, l, (l) == 0 ? 1 : -1); if ((l) == 0) convert_caches(p, c, 1); } \
    SEAM(base + 4);
    LAYER(0, 2)
    LAYER(1, 7)
#undef LAYER
#undef SEAM
#undef IN
}

extern "C" void kernel_launch(void* const* d_in, const int* in_sizes, int n_in, void* d_out, int out_size, void* d_ws, size_t ws_size, hipStream_t stream) {
    static int grid = 0;
    if (grid == 0) {
        if (n_in != 26 || ws_size < WS_END) { fprintf(stderr, "kernel_launch: expected 26 inputs and >= %zu bytes of workspace (got %d, %zu); nothing launched\n", (size_t)WS_END, n_in, ws_size); grid = -1; return; }
        int dev = 0, cus = 0, per_cu = 0;
        if (hipGetDevice(&dev) != hipSuccess || hipDeviceGetAttribute(&cus, hipDeviceAttributeMultiprocessorCount, dev) != hipSuccess) { grid = -1; return; }
        if (false) { fprintf(stderr, "kernel_launch: hipFuncSetAttribute failed\n"); grid = -1; return; }
        if (hipOccupancyMaxActiveBlocksPerMultiprocessor(&per_cu, (const void*)hybrid_fwd, NTHREADS, 0) != hipSuccess || per_cu < 1) { fprintf(stderr, "kernel_launch: occupancy query says %d workgroups per CU; nothing launched\n", per_cu); (void)hipGetLastError(); grid = -1; return; }
        grid = cus;
    }
    if (grid < 0) return;
    (void)hipMemsetAsync((char*)d_ws + WS_CTL, 0, CTL_BYTES, stream);
    Params p{};
    for (int i = 0; i < 26; ++i) p.in[i] = (const float*)d_in[i];
    p.out = (float*)d_out; p.ws = (unsigned char*)d_ws;
#if MK_SPLIT
    for (int ph = 0; ph < N_PHASES; ++ph) { p.ph_lo = ph; p.ph_hi = ph + 1; hipLaunchKernelGGL(hybrid_fwd, dim3(grid), dim3(NTHREADS), 0, stream, p); }
#else
    p.ph_lo = 0; p.ph_hi = N_PHASES;
    hipLaunchKernelGGL(hybrid_fwd, dim3(grid), dim3(NTHREADS), 0, stream, p);
#endif
}
```
